# Optimizing an MI355X kernel written in HIP

```python
import jax, jax.numpy as jnp
from jax import lax
import numpy as np

D_MODEL = 1024
BATCH = 1
SEQ = 16384
DEPTH = 4
DEC_BATCH = 16
DEC_SEQ = 16
PAST_LEN = 4096

CHUNK = 64
HEAD_DIM = 64
N_HEADS = D_MODEL // HEAD_DIM
N_HEADS_A = N_HEADS // 2
N_HEADS_B = N_HEADS - N_HEADS_A
N_HEADS_C = N_HEADS
BAND_CHUNKS = 8
BAND = BAND_CHUNKS * CHUNK
REL_CLIP = 128
D_FF = 4 * D_MODEL
D_PLE = 256
Q_BLOCK = 128
N_EVEN = (DEPTH + 1) // 2
N_ODD = DEPTH // 2
EPS = 1e-6
SCALE = HEAD_DIM ** -0.5

kernel_name = "streaming_hybrid_stickbreak_band_fox_step"


def rms_norm(x, g):
    xf = x.astype(jnp.float32)
    y = xf * lax.rsqrt(jnp.mean(xf * xf, axis=-1, keepdims=True) + EPS)
    return (y * g.astype(jnp.float32)).astype(x.dtype)


def sweep_query_blocks(fn, q, q_pos, *q_side):
    n = q.shape[1]
    if n <= Q_BLOCK:
        return fn(q, q_pos, *q_side)
    nb = n // Q_BLOCK

    def split(a):
        return jnp.moveaxis(a.reshape(a.shape[0], nb, Q_BLOCK, *a.shape[2:]), 1, 0)

    out = lax.map(lambda args: fn(*args), (split(q), q_pos.reshape(nb, Q_BLOCK), *[split(s) for s in q_side]))
    out = jnp.moveaxis(out, 0, 1)
    return out.reshape(q.shape[0], n, *out.shape[3:])


def stick_breaking_block(q, k, v, q_pos, k_pos):
    z = jnp.einsum('bqhd,bkhd->bhqk', q, k).astype(jnp.float32) * SCALE
    visible = k_pos[None, :] < q_pos[:, None]
    log_keep = jnp.where(visible, -jax.nn.softplus(z), 0.0)
    later = lax.cumsum(log_keep, axis=3, reverse=True) - log_keep
    w = jnp.where(visible, jnp.exp(jax.nn.log_sigmoid(z) + later), 0.0)
    return jnp.einsum('bhqk,bkhd->bqhd', w.astype(v.dtype), v)


def band_block(q, k, v, q_pos, k_pos, rel_table):
    logits = jnp.einsum('bqhd,bkhd->bhqk', q, k).astype(jnp.float32) * SCALE
    q_chunk = q_pos // CHUNK
    k_chunk = k_pos // CHUNK
    visible = ((k_pos[None, :] >= 0) & (k_chunk[None, :] <= q_chunk[:, None])
               & (k_chunk[None, :] >= q_chunk[:, None] - BAND_CHUNKS))
    rel = jnp.clip(q_pos[:, None] - k_pos[None, :], -REL_CLIP, REL_CLIP) + REL_CLIP
    logits = logits + rel_table.astype(jnp.float32)[:, rel][None]
    w = jax.nn.softmax(jnp.where(visible, logits, -jnp.inf), axis=-1)
    return jnp.einsum('bhqk,bkhd->bqhd', w.astype(v.dtype), v)


def band_mix_prompt(q, k, v, rel_table):
    B, n, H, d = q.shape
    pad = ((0, 0), (BAND, 0), (0, 0), (0, 0))
    k_pad, v_pad = jnp.pad(k, pad), jnp.pad(v, pad)

    def one_chunk(c):
        start = c * CHUNK
        q_c = lax.dynamic_slice_in_dim(q, start, CHUNK, axis=1)
        k_c = lax.dynamic_slice_in_dim(k_pad, start, BAND + CHUNK, axis=1)
        v_c = lax.dynamic_slice_in_dim(v_pad, start, BAND + CHUNK, axis=1)
        q_pos = start + jnp.arange(CHUNK)
        k_pos = start - BAND + jnp.arange(BAND + CHUNK)
        return band_block(q_c, k_c, v_c, q_pos, k_pos, rel_table)

    out = lax.map(one_chunk, jnp.arange(n // CHUNK))
    return jnp.moveaxis(out, 0, 1).reshape(B, n, H, d)


def forgetting_block(q, dq, k, v, dk, q_pos, k_pos):
    logits = jnp.einsum('bqhd,bkhd->bhqk', q, k).astype(jnp.float32) * SCALE
    logits = logits + jnp.moveaxis(dq, 2, 1)[..., :, None] - jnp.moveaxis(dk, 2, 1)[..., None, :]
    visible = k_pos[None, :] <= q_pos[:, None]
    w = jax.nn.softmax(jnp.where(visible, logits, -jnp.inf), axis=-1)
    return jnp.einsum('bhqk,bkhd->bqhd', w.astype(v.dtype), v)


def even_mixer(xn, w_in, g_qb, g_kb, rel_table, past):
    B, n, _ = xn.shape
    wa, wb = N_HEADS_A * HEAD_DIM, N_HEADS_B * HEAD_DIM
    proj = jnp.einsum('bsd,de->bse', xn, w_in)
    qa, ka, va, qb, kb, vb = jnp.split(proj, [wa, 2 * wa, 3 * wa, 3 * wa + wb, 3 * wa + 2 * wb], axis=-1)
    qa, ka, va = (t.reshape(B, n, N_HEADS_A, HEAD_DIM) for t in (qa, ka, va))
    qb = rms_norm(qb.reshape(B, n, N_HEADS_B, HEAD_DIM), g_qb)
    kb = rms_norm(kb.reshape(B, n, N_HEADS_B, HEAD_DIM), g_kb)
    vb = vb.reshape(B, n, N_HEADS_B, HEAD_DIM)
    if past is None:
        P = 0
        ka_all, va_all = ka, va
        out_b = band_mix_prompt(qb, kb, vb, rel_table)
        keep = min(BAND, n)
        kb_state, vb_state = kb[:, n - keep:], vb[:, n - keep:]
    else:
        pa_k, pa_v, pb_k, pb_v = past
        P, L = pa_k.shape[1], pb_k.shape[1]
        ka_all = jnp.concatenate([pa_k, ka], axis=1)
        va_all = jnp.concatenate([pa_v, va], axis=1)
        kb_all = jnp.concatenate([pb_k, kb], axis=1)
        vb_all = jnp.concatenate([pb_v, vb], axis=1)
        out_b = band_block(qb, kb_all, vb_all, P + jnp.arange(n), P - L + jnp.arange(L + n), rel_table)
        kb_state, vb_state = kb_all[:, n:], vb_all[:, n:]
    q_pos = P + jnp.arange(n)
    k_pos = jnp.arange(P + n)
    out_a = sweep_query_blocks(lambda q_blk, qp: stick_breaking_block(q_blk, ka_all, va_all, qp, k_pos), qa, q_pos)
    mix = jnp.concatenate([out_a, out_b], axis=2).reshape(B, n, N_HEADS * HEAD_DIM)
    return mix, (ka, va, kb_state, vb_state)


def odd_mixer(xn, w_in, b_forget, g_qc, g_kc, past):
    B, n, _ = xn.shape
    w = N_HEADS_C * HEAD_DIM
    proj = jnp.einsum('bsd,de->bse', xn, w_in)
    q, k, v, f = jnp.split(proj, [w, 2 * w, 3 * w], axis=-1)
    q = rms_norm(q.reshape(B, n, N_HEADS_C, HEAD_DIM), g_qc)
    k = rms_norm(k.reshape(B, n, N_HEADS_C, HEAD_DIM), g_kc)
    v = v.reshape(B, n, N_HEADS_C, HEAD_DIM)
    log_f = jax.nn.log_sigmoid(f.astype(jnp.float32) + b_forget.astype(jnp.float32))
    if past is None:
        P = 0
        k_all, v_all, logf_all = k, v, log_f
    else:
        pk, pv, pf = past
        P = pk.shape[1]
        k_all = jnp.concatenate([pk, k], axis=1)
        v_all = jnp.concatenate([pv, v], axis=1)
        logf_all = jnp.concatenate([pf.astype(jnp.float32), log_f], axis=1)
    cum = lax.cumsum(logf_all, axis=1)
    q_pos = P + jnp.arange(n)
    k_pos = jnp.arange(P + n)
    out = sweep_query_blocks(
        lambda q_blk, qp, dq_blk: forgetting_block(q_blk, dq_blk, k_all, v_all, cum, qp, k_pos),
        q, q_pos, cum[:, P:])
    return out.reshape(B, n, w), (k, v, log_f)


def run_trunk(x, p, cache, prm):
    h = x
    a_k, a_v, b_k, b_v, c_k, c_v, c_f = [], [], [], [], [], [], []
    for i in range(DEPTH):
        j = i // 2
        xn = rms_norm(h, prm['g_mix'][i])
        if i % 2 == 0:
            past = None if cache is None else (cache[0][j], cache[1][j], cache[2][j], cache[3][j])
            mix, (ka, va, kb, vb) = even_mixer(xn, prm['w_in_even'][j], prm['g_qb'][j], prm['g_kb'][j],
                                               prm['rel_bias'][j], past)
            a_k.append(ka); a_v.append(va); b_k.append(kb); b_v.append(vb)
        else:
            past = None if cache is None else (cache[4][j], cache[5][j], cache[6][j])
            mix, (kc, vc, fc) = odd_mixer(xn, prm['w_in_odd'][j], prm['b_forget'][j], prm['g_qc'][j],
                                          prm['g_kc'][j], past)
            c_k.append(kc); c_v.append(vc); c_f.append(fc)
        h = h + jnp.einsum('bse,ed->bsd', mix, prm['w_out'][i])
        xn = rms_norm(h, prm['g_mlp'][i])
        hid = jnp.square(jax.nn.relu(jnp.einsum('bsd,df->bsf', xn, prm['w_ff1'][i])))
        h = h + jnp.einsum('bsf,fd->bsd', hid, prm['w_ff2'][i])
        gate = jax.nn.sigmoid(jnp.einsum('bsd,de->bse', rms_norm(h, prm['g_ple'][i]), prm['w_ple_gate'][i]))
        h = h + gate * jnp.einsum('bsp,pd->bsd', p[i], prm['w_ple_proj'][i])
    states = (jnp.stack(a_k), jnp.stack(a_v), jnp.stack(b_k), jnp.stack(b_v),
              jnp.stack(c_k), jnp.stack(c_v), jnp.stack(c_f))
    return h, states


def setup_inputs(seed: int = 0) -> dict:
    key = jax.random.key(seed)
    ks = jax.random.split(key, 32)
    f32 = jnp.float32
    d = HEAD_DIM
    b_len = min(BAND, PAST_LEN)

    def nrm(k, shape, scale=1.0):
        return jax.random.normal(k, shape, f32) * scale

    return {
        'x_prompt': nrm(ks[0], (BATCH, SEQ, D_MODEL)),
        'x_sample': nrm(ks[1], (DEC_BATCH, DEC_SEQ, D_MODEL)),
        'cache_a_k': nrm(ks[2], (N_EVEN, DEC_BATCH, PAST_LEN, N_HEADS_A, d)),
        'cache_a_v': nrm(ks[3], (N_EVEN, DEC_BATCH, PAST_LEN, N_HEADS_A, d)),
        'cache_b_k': nrm(ks[4], (N_EVEN, DEC_BATCH, b_len, N_HEADS_B, d)),
        'cache_b_v': nrm(ks[5], (N_EVEN, DEC_BATCH, b_len, N_HEADS_B, d)),
        'cache_c_k': nrm(ks[6], (N_ODD, DEC_BATCH, PAST_LEN, N_HEADS_C, d)),
        'cache_c_v': nrm(ks[7], (N_ODD, DEC_BATCH, PAST_LEN, N_HEADS_C, d)),
        'cache_c_logf': jax.nn.log_sigmoid(3.0 + nrm(ks[8], (N_ODD, DEC_BATCH, PAST_LEN, N_HEADS_C), 1.5)),
        'p_prompt': nrm(ks[9], (DEPTH, BATCH, SEQ, D_PLE)),
        'p_sample': nrm(ks[10], (DEPTH, DEC_BATCH, DEC_SEQ, D_PLE)),
        'g_mix': 1.0 + nrm(ks[11], (DEPTH, D_MODEL), 0.02),
        'w_in_even': nrm(ks[12], (N_EVEN, D_MODEL, 3 * (N_HEADS_A + N_HEADS_B) * d), D_MODEL ** -0.5),
        'g_qb': 1.0 + nrm(ks[13], (N_EVEN, d), 0.02),
        'g_kb': 1.0 + nrm(ks[14], (N_EVEN, d), 0.02),
        'rel_bias': nrm(ks[15], (N_EVEN, N_HEADS_B, 2 * REL_CLIP + 1), 0.5),
        'w_in_odd': nrm(ks[16], (N_ODD, D_MODEL, 3 * N_HEADS_C * d + N_HEADS_C), D_MODEL ** -0.5),
        'b_forget': jax.random.uniform(ks[17], (N_ODD, N_HEADS_C), f32, 1.0, 6.0),
        'g_qc': 1.0 + nrm(ks[18], (N_ODD, d), 0.02),
        'g_kc': 1.0 + nrm(ks[19], (N_ODD, d), 0.02),
        'w_out': nrm(ks[20], (DEPTH, N_HEADS * d, D_MODEL), (N_HEADS * d) ** -0.5),
        'g_mlp': 1.0 + nrm(ks[21], (DEPTH, D_MODEL), 0.02),
        'w_ff1': nrm(ks[22], (DEPTH, D_MODEL, D_FF), D_MODEL ** -0.5),
        'w_ff2': nrm(ks[23], (DEPTH, D_FF, D_MODEL), D_FF ** -0.5),
        'g_ple': 1.0 + nrm(ks[24], (DEPTH, D_MODEL), 0.02),
        'w_ple_gate': nrm(ks[25], (DEPTH, D_MODEL, D_MODEL), D_MODEL ** -0.5),
        'w_ple_proj': nrm(ks[26], (DEPTH, D_PLE, D_MODEL), D_PLE ** -0.5),
    }


def reference(x_prompt, x_sample, cache_a_k, cache_a_v, cache_b_k, cache_b_v, cache_c_k, cache_c_v,
              cache_c_logf, p_prompt, p_sample, g_mix, w_in_even, g_qb, g_kb, rel_bias, w_in_odd,
              b_forget, g_qc, g_kc, w_out, g_mlp, w_ff1, w_ff2, g_ple, w_ple_gate, w_ple_proj):
    prm = {'g_mix': g_mix, 'w_in_even': w_in_even, 'g_qb': g_qb, 'g_kb': g_kb, 'rel_bias': rel_bias,
           'w_in_odd': w_in_odd, 'b_forget': b_forget, 'g_qc': g_qc, 'g_kc': g_kc, 'w_out': w_out,
           'g_mlp': g_mlp, 'w_ff1': w_ff1, 'w_ff2': w_ff2, 'g_ple': g_ple, 'w_ple_gate': w_ple_gate,
           'w_ple_proj': w_ple_proj}
    y_prompt, st_p = run_trunk(x_prompt, p_prompt, None, prm)
    cache = (cache_a_k, cache_a_v, cache_b_k, cache_b_v, cache_c_k, cache_c_v, cache_c_logf)
    y_sample, st_s = run_trunk(x_sample, p_sample, cache, prm)
    pa_k, pa_v, pb_k, pb_v, pc_k, pc_v, pc_f = st_p
    sa_k, sa_v, sb_k, sb_v, sc_k, sc_v, sc_f = st_s
    return (y_prompt, y_sample, pa_k, pa_v, pb_k, pb_v, pc_k, pc_v, pc_f,
            sa_k, sa_v, sb_k, sb_v, sc_k, sc_v, sc_f)
```

```cpp
#define STAGE_BOTH_MASK 4
#define SMP_RATIO 4
#define STICK_PRE 0
#define EVEN_PARITY 0
#include <hip/hip_runtime.h>
#include <cstdio>
#include <cstdint>

constexpr int DM = 1024, SEQ = 16384, NSMP = 256, MROWS = SEQ + NSMP, FF = 4096, DPLE = 256, HD = 64, NH = 16, PAST = 4096, BANDL = 512, DEPTH = 4;
constexpr int NPANEL = MROWS / 256;
constexpr float RMS_EPS = 1e-6f;
constexpr float LOG2E = 1.4426950408889634f;
constexpr float QSCALE = 0.125f * LOG2E;
constexpr size_t O_Y = 0;
constexpr size_t O_PAK = O_Y + (size_t)MROWS * DM;
constexpr size_t O_PAV = O_PAK + (size_t)2 * SEQ * 512;
constexpr size_t O_PBK = O_PAV + (size_t)2 * SEQ * 512;
constexpr size_t O_PBV = O_PBK + (size_t)2 * 512 * 512;
constexpr size_t O_PCK = O_PBV + (size_t)2 * 512 * 512;
constexpr size_t O_PCV = O_PCK + (size_t)2 * SEQ * 1024;
constexpr size_t O_PCF = O_PCV + (size_t)2 * SEQ * 1024;
constexpr size_t O_SAK = O_PCF + (size_t)2 * SEQ * 16;
constexpr size_t O_SAV = O_SAK + (size_t)2 * NSMP * 512;
constexpr size_t O_SBK = O_SAV + (size_t)2 * NSMP * 512;
constexpr size_t O_SBV = O_SBK + (size_t)2 * 16 * 512 * 512;
constexpr size_t O_SCK = O_SBV + (size_t)2 * 16 * 512 * 512;
constexpr size_t O_SCV = O_SCK + (size_t)2 * NSMP * 1024;
constexpr size_t O_SCF = O_SCV + (size_t)2 * NSMP * 1024;
constexpr size_t O_END = O_SCF + (size_t)2 * NSMP * 16;
static_assert(O_END == 137633792ull, "output size");
#ifndef PG8_WGM
#define PG8_WGM 8
#endif
namespace pg8 {
#define PG8_LAS __attribute__((address_space(3)))
typedef unsigned short bf16_t;
typedef short bf16x8 __attribute__((ext_vector_type(8)));
typedef float f32x4 __attribute__((ext_vector_type(4)));
typedef unsigned u32x4 __attribute__((ext_vector_type(4)));
constexpr int BM = 256, BK = 64, HALF = 128, HTB = HALF * BK * 2  , STAGE_BYTES = 8 * HTB, NXCD = 8, WGM = PG8_WGM;

__host__ __device__ __forceinline__ int lds_byte(int r, int c) { const int st = (r >> 4) * 2 + (c >> 5), rr = r & 15, cc = c & 31, ob = rr * 64 + cc * 2; return st * 1024 + (ob ^ (((ob >> 9) & 1) << 5)); }
__host__ __device__ __forceinline__ void stage_rc(int b, int& R, int& C) { const int st = b / 1024, sb = b % 1024, swz = sb ^ (((sb >> 9) & 1) << 5); R = (st >> 1) * 16 + swz / 64; C = (st & 1) * 32 + (swz % 64) / 2; }
__host__ __device__ __forceinline__ int perm32(int rho) { const int n = rho >> 4, i = rho & 15; return 8 * (i >> 2) + 4 * n + (i & 3); }

struct Unit { int pm, pn; };
struct Gemm { const bf16_t* A; const bf16_t* Bt; int M, N, K; };

struct StaticOrder {
    int nM, nN, nwg, G, c;
    __host__ __device__ void init(int M, int N, int G_, int c_) { nM = M / BM; nN = N / BM; nwg = nM * nN; G = G_; c = c_; }
    __host__ __device__ bool next(int i, Unit& u) const {
        const int L = i * G + c; if (L >= nwg) return false;
        int wgid = L; { const int q = nwg / NXCD, r = nwg % NXCD, xcd = wgid % NXCD, off = wgid / NXCD; wgid = (xcd < r ? xcd * (q + 1) : r * (q + 1) + (xcd - r) * q) + off; }
        const int nig = WGM * nN, gid = wgid / nig, fm = gid * WGM, gsz = (nM - fm) < WGM ? (nM - fm) : WGM;
        u.pm = fm + ((wgid % nig) % gsz); u.pn = (wgid % nig) / gsz; return true;
    }
    __device__ __forceinline__ void a_ready(const Unit&) const {}
    __device__ __forceinline__ void done(const Unit&) const {}
};
__device__ __forceinline__ unsigned cvt_pk_bf16(float lo, float hi) { unsigned r; asm volatile("v_cvt_pk_bf16_f32 %0, %1, %2" : "=v"(r) : "v"(lo), "v"(hi)); return r; }
typedef float f32x2 __attribute__((ext_vector_type(2)));
template <class Epi, class Sched, bool ALIGN_EPI = false, bool SP2 = false>
__device__ __forceinline__ void gemm_phase(PG8_LAS unsigned char* lds, const Gemm g, const Sched& S, const Epi& E, int tid_in) {
    int tid_ = tid_in; asm volatile("" : "+v"(tid_));
    const int tid = tid_, wid = __builtin_amdgcn_readfirstlane(tid >> 6), lane = tid & 63, wr = wid >> 2, wc = wid & 3, fr = lane & 15, fq = lane >> 4;
    const int K = g.K, nt = K / BK;
    unsigned voffA[2], voffB[2];
#pragma unroll
    for (int i = 0; i < 2; ++i) { int R, C; stage_rc(tid * 16 + i * 8192, R, C); const int Rb = Epi::PERM ? ((R & ~31) + perm32(R & 31)) : R;
        voffA[i] = (unsigned)(R * K + C) * 2u; voffB[i] = (unsigned)(Rb * K + C) * 2u; }
    const size_t kstep = (size_t)(BK * 2);
    const size_t hstep = (size_t)HALF * K * 2;
    const size_t tstep = 2 * hstep;
    const unsigned ldsw = (unsigned)wid * 1024u;
    const int aoff = lds_byte(wr * 64 + fr, fq * 8), boff = lds_byte(wc * 32 + fr, fq * 8);
#define PG8_SA(b, h) (((b) * 2 + (h)) * HTB)
#define PG8_SB(b, h) ((4 + (b) * 2 + (h)) * HTB)
#ifndef PG8_AUX_A
#define PG8_AUX_A 0
#endif
#ifndef PG8_AUX_B
#define PG8_AUX_B 0
#endif
#define PG8_AUX_voffA PG8_AUX_A
#define PG8_AUX_voffB PG8_AUX_B
#define PG8_STAGE(bufoff, gbase, voff) do { _Pragma("unroll") for (int _i = 0; _i < 2; ++_i) \
        __builtin_amdgcn_global_load_lds((const unsigned*)((const char*)(gbase) + (voff)[_i]), (PG8_LAS unsigned*)(lds + (bufoff) + ldsw + _i * 8192), 16, 0, PG8_AUX_##voff); } while (0)
#define PG8_LDA(dst, b, h) do { _Pragma("unroll") for (int m = 0; m < 4; ++m) _Pragma("unroll") for (int k = 0; k < 2; ++k) dst[m][k] = *(const PG8_LAS bf16x8*)(lds + PG8_SA(b, h) + aoff + m * 2048 + k * 1024); } while (0)
#define PG8_LDB(dst, b, h) do { _Pragma("unroll") for (int n = 0; n < 2; ++n) _Pragma("unroll") for (int k = 0; k < 2; ++k) dst[n][k] = *(const PG8_LAS bf16x8*)(lds + PG8_SB(b, h) + boff + n * 2048 + k * 1024); } while (0)
#define PG8_MMA(ai, bj, At, Bt) do { __builtin_amdgcn_s_setprio(1); _Pragma("unroll") for (int m = 0; m < 4; ++m) _Pragma("unroll") for (int n = 0; n < 2; ++n) _Pragma("unroll") for (int k = 0; k < 2; ++k) \
        acc[ai][bj][m][n] = __builtin_amdgcn_mfma_f32_16x16x32_bf16(Bt[n][k], At[m][k], acc[ai][bj][m][n], 0, 0, 0); __builtin_amdgcn_s_setprio(0); } while (0)
#define PG8_WAIT_V(n) asm volatile("s_waitcnt vmcnt(" #n ")" ::: "memory")
#define PG8_WAIT_L(n) asm volatile("s_waitcnt lgkmcnt(" #n ")" ::: "memory")
#define PG8_BAR __builtin_amdgcn_s_barrier()
#define PG8_SCHED __builtin_amdgcn_sched_barrier(0)
    Unit cur, nxt; int ui = 0;
    if (!S.next(0, cur)) return;
    f32x4 acc[2][2][4][2];
#pragma unroll
    for (int a = 0; a < 2; ++a)
#pragma unroll
        for (int b = 0; b < 2; ++b)
#pragma unroll
            for (int m = 0; m < 4; ++m)
#pragma unroll
                for (int n = 0; n < 2; ++n) acc[a][b][m][n] = (f32x4){0.f, 0.f, 0.f, 0.f};
    bf16x8 At[4][2], B0[2][2], B1[2][2];
    const char* cA = (const char*)g.A + (size_t)cur.pm * tstep; const char* cB = (const char*)g.Bt + (size_t)cur.pn * tstep;
    S.a_ready(cur);
    if constexpr (SP2) {
        PG8_STAGE(PG8_SB(0, 0), cB, voffB); PG8_STAGE(PG8_SB(0, 1), cB + hstep, voffB); PG8_STAGE(PG8_SA(0, 0), cA, voffA); PG8_STAGE(PG8_SA(0, 1), cA + hstep, voffA);
        if (wr == 1) PG8_BAR;
        PG8_WAIT_V(2); PG8_BAR;
        PG8_STAGE(PG8_SB(1, 0), cB + kstep, voffB); PG8_STAGE(PG8_SA(1, 0), cA + kstep, voffA); PG8_STAGE(PG8_SB(1, 1), cB + hstep + kstep, voffB);
        PG8_WAIT_V(6); PG8_BAR;
    } else {
        PG8_STAGE(PG8_SB(0, 0), cB, voffB); PG8_STAGE(PG8_SA(0, 0), cA, voffA); PG8_STAGE(PG8_SB(0, 1), cB + hstep, voffB); PG8_STAGE(PG8_SA(0, 1), cA + hstep, voffA);
        if (wr == 1) PG8_BAR;
        PG8_WAIT_V(4); PG8_BAR;
        PG8_STAGE(PG8_SB(1, 0), cB + kstep, voffB); PG8_STAGE(PG8_SA(1, 0), cA + kstep, voffA); PG8_STAGE(PG8_SB(1, 1), cB + hstep + kstep, voffB);
        PG8_WAIT_V(6); PG8_BAR;
    }
    for (;;) {
        const bool has_next = S.next(ui + 1, nxt);
        const char* nA = has_next ? (const char*)g.A + (size_t)nxt.pm * tstep : cA; const char* nB = has_next ? (const char*)g.Bt + (size_t)nxt.pn * tstep : cB;
        for (int t = 0; t < nt; t += 2) {
            const bool last = (t == nt - 2);
            const char* a1 = cA + (size_t)(t + 1) * kstep;
            const char* a2 = last ? nA : cA + (size_t)(t + 2) * kstep; const char* b2 = last ? nB : cB + (size_t)(t + 2) * kstep;
            const char* a3 = a2 + kstep; const char* b3 = b2 + kstep;
            if (last && has_next) S.a_ready(nxt);
            if constexpr (SP2) {
            PG8_LDB(B0, 0, 0); PG8_LDB(B1, 0, 1); PG8_SCHED; PG8_LDA(At, 0, 0); PG8_STAGE(PG8_SA(1, 1), a1 + hstep, voffA);
            PG8_WAIT_V(8); PG8_WAIT_L(0); PG8_BAR; PG8_MMA(0, 0, At, B0); PG8_MMA(0, 1, At, B1); PG8_BAR; PG8_SCHED;
            PG8_LDA(At, 0, 1); PG8_STAGE(PG8_SB(0, 0), b2, voffB); PG8_STAGE(PG8_SB(0, 1), b2 + hstep, voffB); PG8_STAGE(PG8_SA(0, 0), a2, voffA);
            PG8_WAIT_V(8); PG8_WAIT_L(0); PG8_BAR; PG8_MMA(1, 0, At, B0); PG8_MMA(1, 1, At, B1); PG8_BAR; PG8_SCHED;
            PG8_LDB(B0, 1, 0); PG8_LDB(B1, 1, 1); PG8_SCHED; PG8_LDA(At, 1, 0); PG8_STAGE(PG8_SA(0, 1), a2 + hstep, voffA);
            PG8_WAIT_V(8); PG8_WAIT_L(0); PG8_BAR; PG8_MMA(0, 0, At, B0); PG8_MMA(0, 1, At, B1); PG8_BAR; PG8_SCHED;
            PG8_LDA(At, 1, 1); PG8_STAGE(PG8_SB(1, 0), b3, voffB); PG8_STAGE(PG8_SB(1, 1), b3 + hstep, voffB); PG8_STAGE(PG8_SA(1, 0), a3, voffA);
            PG8_WAIT_V(8); PG8_WAIT_L(0); PG8_BAR; PG8_MMA(1, 0, At, B0); PG8_MMA(1, 1, At, B1); PG8_BAR; PG8_SCHED;
            } else {
            PG8_LDB(B0, 0, 0); PG8_SCHED; PG8_LDA(At, 0, 0); PG8_STAGE(PG8_SA(1, 1), a1 + hstep, voffA);
            PG8_WAIT_L(8); PG8_BAR; PG8_WAIT_L(0); PG8_MMA(0, 0, At, B0); PG8_BAR; PG8_SCHED;
            PG8_LDB(B1, 0, 1); PG8_STAGE(PG8_SB(0, 0), b2, voffB);
            PG8_BAR; PG8_WAIT_L(0); PG8_MMA(0, 1, At, B1); PG8_BAR;
            PG8_LDA(At, 0, 1); PG8_STAGE(PG8_SA(0, 0), a2, voffA);
            PG8_BAR; PG8_WAIT_L(0); PG8_MMA(1, 0, At, B0); PG8_BAR; PG8_SCHED;
            PG8_STAGE(PG8_SB(0, 1), b2 + hstep, voffB);
            PG8_WAIT_V(6); PG8_BAR; PG8_MMA(1, 1, At, B1); PG8_BAR;
            PG8_LDB(B0, 1, 0); PG8_SCHED; PG8_LDA(At, 1, 0); PG8_STAGE(PG8_SA(0, 1), a2 + hstep, voffA);
            PG8_WAIT_L(8); PG8_BAR; PG8_WAIT_L(0); PG8_MMA(0, 0, At, B0); PG8_BAR; PG8_SCHED;
            PG8_LDB(B1, 1, 1); PG8_STAGE(PG8_SB(1, 0), b3, voffB);
            PG8_BAR; PG8_WAIT_L(0); PG8_MMA(0, 1, At, B1); PG8_BAR;
            PG8_LDA(At, 1, 1); PG8_STAGE(PG8_SA(1, 0), a3, voffA);
            PG8_BAR; PG8_WAIT_L(0); PG8_MMA(1, 0, At, B0); PG8_BAR; PG8_SCHED;
            PG8_STAGE(PG8_SB(1, 1), b3 + hstep, voffB);
            PG8_WAIT_V(6); PG8_BAR; PG8_MMA(1, 1, At, B1); PG8_BAR;
            }
        }
        if constexpr (ALIGN_EPI) { if (wr == 0) PG8_BAR; }
        if constexpr (!Epi::AFTER_DRAIN) { E(acc, cur, wr, wc, fr, fq); S.done(cur); }
        if (!has_next) break;
#pragma unroll
        for (int a = 0; a < 2; ++a)
#pragma unroll
            for (int b = 0; b < 2; ++b)
#pragma unroll
                for (int m = 0; m < 4; ++m)
#pragma unroll
                    for (int n = 0; n < 2; ++n) acc[a][b][m][n] = (f32x4){0.f, 0.f, 0.f, 0.f};
        cur = nxt; cA = nA; cB = nB; ++ui;
        if constexpr (ALIGN_EPI) { if (wr == 1) PG8_BAR; }
    }
    PG8_WAIT_V(0);
    if constexpr (!ALIGN_EPI) { if (wr == 0) PG8_BAR; }
    PG8_BAR;
    if constexpr (Epi::AFTER_DRAIN) { E.fused(acc, cur, wr, wc, fr, fq, lds, wid, lane); S.done(cur); }
#undef PG8_SA
#undef PG8_SB
#undef PG8_STAGE
#undef PG8_LDA
#undef PG8_LDB
#undef PG8_MMA
#undef PG8_WAIT_V
#undef PG8_WAIT_L
#undef PG8_BAR
#undef PG8_SCHED
}
}

namespace pg8 {
typedef unsigned u32x2 __attribute__((ext_vector_type(2)));
__device__ __forceinline__ float rsq_f(float x) { return __builtin_amdgcn_rsqf(x); }
__device__ __forceinline__ float row_rscale(const float* ssq, int row) {
    const f32x4* p = (const f32x4*)(ssq + (size_t)row * 16);
    const f32x4 a = p[0], b = p[1], c = p[2], d = p[3];
    const f32x4 s = (a + b) + (c + d);
    return rsq_f(((s[0] + s[1]) + (s[2] + s[3])) * (1.0f / 1024.0f) + RMS_EPS);
}
__device__ __forceinline__ void row_rscale8(const float* ssq, int row0, int fq, float (&r)[2][4]) {
    f32x4 p[2][4];
#pragma unroll
    for (int ai = 0; ai < 2; ++ai)
#pragma unroll
        for (int m = 0; m < 4; ++m) p[ai][m] = *(const f32x4*)(ssq + (size_t)(row0 + ai * HALF + m * 16) * 16 + 4 * fq);
#pragma unroll
    for (int ai = 0; ai < 2; ++ai)
#pragma unroll
        for (int m = 0; m < 4; ++m) { float s = (p[ai][m][0] + p[ai][m][1]) + (p[ai][m][2] + p[ai][m][3]); s += __shfl_xor(s, 16); s += __shfl_xor(s, 32); r[ai][m] = rsq_f(s * (1.0f / 1024.0f) + RMS_EPS); }
}
__device__ __forceinline__ float log_sigmoid_f(float x) { return fminf(x, 0.f) - 0.6931471805599453f * __builtin_amdgcn_logf(1.0f + __builtin_amdgcn_exp2f(-1.4426950408889634f * fabsf(x))); }
__device__ __forceinline__ float sumsq4(const f32x4 v) { return (v[0] * v[0] + v[1] * v[1]) + (v[2] * v[2] + v[3] * v[3]); }
__device__ __forceinline__ u32x4 pack8(const f32x4 a, const f32x4 b) { u32x4 w; w.x = cvt_pk_bf16(a[0], a[1]); w.y = cvt_pk_bf16(a[2], a[3]); w.z = cvt_pk_bf16(b[0], b[1]); w.w = cvt_pk_bf16(b[2], b[3]); return w; }

__device__ __forceinline__ float* kv_dst(float* out, int odd, int j, int t  , int hd, int row) {
    const bool smp = row >= SEQ; const int rs = row - SEQ;
    if (odd) {
        const size_t base = smp ? (t == 1 ? O_SCK : O_SCV) : (t == 1 ? O_PCK : O_PCV);
        const size_t r = smp ? (size_t)(j * NSMP + rs) : (size_t)j * SEQ + row;
        return out + base + (r * 16 + hd) * 64;
    }
    if (hd < 8) {
        const size_t base = smp ? (t == 1 ? O_SAK : O_SAV) : (t == 1 ? O_PAK : O_PAV);
        const size_t r = smp ? (size_t)(j * NSMP + rs) : (size_t)j * SEQ + row;
        return out + base + (r * 8 + hd) * 64;
    }
    if (smp) { const int b = rs >> 4, tt = rs & 15; return out + (t == 1 ? O_SBK : O_SBV) + ((size_t)((j * 16 + b) * 512 + 496 + tt) * 8 + (hd - 8)) * 64; }
    if (row < SEQ - 512) return nullptr;
    return out + (t == 1 ? O_PBK : O_PBV) + ((size_t)(j * 512 + row - (SEQ - 512)) * 8 + (hd - 8)) * 64;
}

struct EpiIn {
    static constexpr bool PERM = true, AFTER_DRAIN = false;
    const float* ssq; bf16_t* Qb; float* out; const float *gq; long long gk_minus_gq; int odd, j;
    __device__ __forceinline__ void operator()(const f32x4 (&acc)[2][2][4][2], const Unit& u, int wr, int wc, int fr_in, int fq_in) const {
        int fr = fr_in, fq = fq_in; asm volatile("" : "+v"(fr), "+v"(fq));
        const int row0 = u.pm * BM + wr * 64 + fr;
        float rr[2][4]; row_rscale8(ssq, row0, fq, rr);
        const int t = u.pn >> 2, hd = (u.pn & 3) * 4 + wc;
        const bool norm = (t < 2) && (odd || hd >= 8);
        const float* g = (const float*)((const char*)gq + (t == 1 ? gk_minus_gq : 0ll));
        f32x4 gv[2][2];
#pragma unroll
        for (int bj = 0; bj < 2; ++bj)
#pragma unroll
            for (int n = 0; n < 2; ++n) gv[bj][n] = norm ? *(const f32x4*)(g + 32 * bj + 8 * fq + 4 * n) : (f32x4){1.f, 1.f, 1.f, 1.f};
        bf16_t* ob = Qb + (size_t)t * ((size_t)MROWS * DM);
        const int colh = hd * 64 + 8 * fq;
#pragma unroll
        for (int ai = 0; ai < 2; ++ai)
#pragma unroll
            for (int m = 0; m < 4; ++m) {
                const int row = row0 + ai * HALF + m * 16; const float r = rr[ai][m];
                f32x4 v[2][2]; float s = 0.f;
#pragma unroll
                for (int bj = 0; bj < 2; ++bj)
#pragma unroll
                    for (int n = 0; n < 2; ++n) { v[bj][n] = acc[ai][bj][m][n] * r; s += sumsq4(v[bj][n]); }
                if (norm) {
                    s += __shfl_xor(s, 16); s += __shfl_xor(s, 32);
                    const float rs = rsq_f(s * (1.0f / 64.0f) + RMS_EPS);
#pragma unroll
                    for (int bj = 0; bj < 2; ++bj)
#pragma unroll
                        for (int n = 0; n < 2; ++n) v[bj][n] = v[bj][n] * rs * gv[bj][n];
                }
                bf16_t* orow = ob + (size_t)row * DM + colh;
                if (t == 0) {
#pragma unroll
                    for (int bj = 0; bj < 2; ++bj) *(u32x4*)(orow + 32 * bj) = pack8(v[bj][0] * QSCALE, v[bj][1] * QSCALE);
                } else {
#pragma unroll
                    for (int bj = 0; bj < 2; ++bj) *(u32x4*)(orow + 32 * bj) = pack8(v[bj][0], v[bj][1]);
                }
                if (m == 3) asm volatile("" ::: "memory");
            }
    }
};

__device__ __forceinline__ float bf_lo(unsigned w) { return __uint_as_float(w << 16); }
__device__ __forceinline__ float bf_hi(unsigned w) { return __uint_as_float(w & 0xffff0000u); }
__device__ __forceinline__ void unpack8(const u32x4 w, f32x4& a, f32x4& b) { a = (f32x4){bf_lo(w.x), bf_hi(w.x), bf_lo(w.y), bf_hi(w.y)}; b = (f32x4){bf_lo(w.z), bf_hi(w.z), bf_lo(w.w), bf_hi(w.w)}; }
struct EpiRes {
    static constexpr bool PERM = true, AFTER_DRAIN = false;
    const bf16_t* hb_in; bf16_t* hb_out; float* ssq;
    __device__ __forceinline__ void operator()(const f32x4 (&acc)[2][2][4][2], const Unit& u, int wr, int wc, int fr_in, int fq_in) const {
        int fr = fr_in, fq = fq_in; asm volatile("" : "+v"(fr), "+v"(fq));
        const int row0 = u.pm * BM + wr * 64 + fr, col0 = u.pn * BM + wc * 32 + 8 * fq;
#pragma unroll
        for (int ai = 0; ai < 2; ++ai)
#pragma unroll
            for (int m = 0; m < 4; ++m) {
                const int row = row0 + ai * HALF + m * 16;
                float s = 0.f;
#pragma unroll
                for (int bj = 0; bj < 2; ++bj) {
                    const size_t off = (size_t)row * DM + col0 + bj * HALF;
                    f32x4 h0, h1; unpack8(*(const u32x4*)(hb_in + off), h0, h1);
                    const f32x4 o0 = acc[ai][bj][m][0] + h0, o1 = acc[ai][bj][m][1] + h1;
                    *(u32x4*)(hb_out + off) = pack8(o0, o1);
                    s += sumsq4(o0) + sumsq4(o1);
                }
                s += __shfl_xor(s, 16); s += __shfl_xor(s, 32);
                if (fq == 0) ssq[(size_t)row * 16 + u.pn * 4 + wc] = s;
                if (m == 3) asm volatile("" ::: "memory");
            }
    }
};

struct EpiFf1 {
    static constexpr bool PERM = true, AFTER_DRAIN = false;
    const float* ssq; bf16_t* hid;
    __device__ __forceinline__ void operator()(const f32x4 (&acc)[2][2][4][2], const Unit& u, int wr, int wc, int fr_in, int fq_in) const {
        int fr = fr_in, fq = fq_in; asm volatile("" : "+v"(fr), "+v"(fq));
        const int row0 = u.pm * BM + wr * 64 + fr, col0 = u.pn * BM + wc * 32 + 8 * fq;
        float rr[2][4]; row_rscale8(ssq, row0, fq, rr);
#pragma unroll
        for (int ai = 0; ai < 2; ++ai)
#pragma unroll
            for (int m = 0; m < 4; ++m) {
                const int row = row0 + ai * HALF + m * 16; const float r = rr[ai][m];
#pragma unroll
                for (int bj = 0; bj < 2; ++bj) {
                    f32x4 a = acc[ai][bj][m][0] * r, b = acc[ai][bj][m][1] * r;
#pragma unroll
                    for (int i = 0; i < 4; ++i) { const float x = fmaxf(a[i], 0.f), y = fmaxf(b[i], 0.f); a[i] = x * x; b[i] = y * y; }
                    *(u32x4*)(hid + (size_t)row * FF + col0 + bj * HALF) = pack8(a, b);
                }
                if (m == 3) asm volatile("" ::: "memory");
            }
    }
};

struct EpiPP {
    static constexpr bool PERM = true, AFTER_DRAIN = false;
    bf16_t* pp;
    __device__ __forceinline__ void operator()(const f32x4 (&acc)[2][2][4][2], const Unit& u, int wr, int wc, int fr_in, int fq_in) const {
        int fr = fr_in, fq = fq_in; asm volatile("" : "+v"(fr), "+v"(fq));
        const int row0 = u.pm * BM + wr * 64 + fr, col0 = u.pn * BM + wc * 32 + 8 * fq;
#pragma unroll
        for (int ai = 0; ai < 2; ++ai)
#pragma unroll
            for (int m = 0; m < 4; ++m) {
                const int row = row0 + ai * HALF + m * 16;
#pragma unroll
                for (int bj = 0; bj < 2; ++bj) *(u32x4*)(pp + (size_t)row * DM + col0 + bj * HALF) = pack8(acc[ai][bj][m][0], acc[ai][bj][m][1]);
                if (m == 3) asm volatile("" ::: "memory");
            }
    }
};

struct EpiGate {
    static constexpr bool PERM = true, AFTER_DRAIN = false;
    const float* ssq_in; const bf16_t* pp; const bf16_t* hb_in; bf16_t* hb_out; float* ssq_out; float* yout;
    __device__ __forceinline__ void operator()(const f32x4 (&acc)[2][2][4][2], const Unit& u, int wr, int wc, int fr_in, int fq_in) const {
        int fr = fr_in, fq = fq_in; asm volatile("" : "+v"(fr), "+v"(fq));
        const int row0 = u.pm * BM + wr * 64 + fr, col0 = u.pn * BM + wc * 32 + 8 * fq;
        float rr[2][4]; row_rscale8(ssq_in, row0, fq, rr);
#pragma unroll
        for (int ai = 0; ai < 2; ++ai)
#pragma unroll
            for (int m = 0; m < 4; ++m) {
                const int row = row0 + ai * HALF + m * 16; const float r = rr[ai][m];
                float s = 0.f;
#pragma unroll
                for (int bj = 0; bj < 2; ++bj) {
                    const size_t off = (size_t)row * DM + col0 + bj * HALF;
                    f32x4 p0, p1, o0, o1; unpack8(*(const u32x4*)(pp + off), p0, p1); unpack8(*(const u32x4*)(hb_in + off), o0, o1);
                    const f32x4 a = acc[ai][bj][m][0] * (-r * LOG2E), b = acc[ai][bj][m][1] * (-r * LOG2E);
#pragma unroll
                    for (int i = 0; i < 4; ++i) {
                        o0[i] += __builtin_amdgcn_rcpf(1.0f + __builtin_amdgcn_exp2f(a[i])) * p0[i];
                        o1[i] += __builtin_amdgcn_rcpf(1.0f + __builtin_amdgcn_exp2f(b[i])) * p1[i];
                    }
                    if (yout) { __builtin_nontemporal_store(o0, (f32x4*)(yout + off)); __builtin_nontemporal_store(o1, (f32x4*)(yout + off + 4)); }
                    *(u32x4*)(hb_out + off) = pack8(o0, o1);
                    s += sumsq4(o0) + sumsq4(o1);
                }
                s += __shfl_xor(s, 16); s += __shfl_xor(s, 32);
                if (fq == 0) ssq_out[(size_t)row * 16 + u.pn * 4 + wc] = s;
                if (m == 3) asm volatile("" ::: "memory");
            }
    }
};
}

namespace att {
#define ALDS __attribute__((address_space(3)))
typedef ALDS unsigned char* lptr;
typedef unsigned short bf16;
typedef short bf16x8 __attribute__((ext_vector_type(8)));
typedef short s16x4 __attribute__((ext_vector_type(4)));
typedef float f32x16 __attribute__((ext_vector_type(16)));
typedef float f32x4 __attribute__((ext_vector_type(4)));
typedef unsigned u32x4 __attribute__((ext_vector_type(4)));
typedef unsigned u32x2 __attribute__((ext_vector_type(2)));
constexpr float NEG_INF = -INFINITY;

__device__ __forceinline__ int crow(int r, int hi) { return (r & 3) + 8 * (r >> 2) + 4 * hi; }
__device__ __forceinline__ unsigned cvtpk(float lo, float hi) { unsigned r; asm volatile("v_cvt_pk_bf16_f32 %0, %1, %2" : "=v"(r) : "v"(lo), "v"(hi)); return r; }
__device__ __forceinline__ float ex2(float x) { return __builtin_amdgcn_exp2f(x); }
__device__ __forceinline__ float lg2(float x) { return __builtin_amdgcn_logf(x); }
__device__ __forceinline__ void pair_vals(float x, float& lo, float& hi) {
    auto rr = __builtin_amdgcn_permlane32_swap(__float_as_uint(x), __float_as_uint(x), false, false);
    lo = __uint_as_float(rr[0]); hi = __uint_as_float(rr[1]);
}

__device__ __forceinline__ void qkt(f32x16& p0, f32x16& p1, lptr Ks, const bf16x8 (&qr)[4], int r32, int hi) {
    const lptr kb = Ks + hi * 1024 + r32 * 16;
    f32x16 a = {}, b = {};
#pragma unroll
    for (int d0 = 0; d0 < 4; ++d0) {
        const bf16x8 b0 = *(const ALDS bf16x8*)(kb + d0 * 2048), b1 = *(const ALDS bf16x8*)(kb + d0 * 2048 + 512);
        a = __builtin_amdgcn_mfma_f32_32x32x16_bf16(b0, qr[d0], a, 0, 0, 0);
        b = __builtin_amdgcn_mfma_f32_32x32x16_bf16(b1, qr[d0], b, 0, 0, 0);
    }
    p0 = a; p1 = b;
}
__device__ __forceinline__ void pv(f32x16 (&o)[2], int vb, const f32x16& p0, const f32x16& p1) {
    u32x4 pw[4];
#pragma unroll
    for (int k = 0; k < 2; ++k) {
        pw[k]     = (u32x4){cvtpk(p0[8 * k], p0[8 * k + 1]), cvtpk(p0[8 * k + 2], p0[8 * k + 3]), cvtpk(p0[8 * k + 4], p0[8 * k + 5]), cvtpk(p0[8 * k + 6], p0[8 * k + 7])};
        pw[2 + k] = (u32x4){cvtpk(p1[8 * k], p1[8 * k + 1]), cvtpk(p1[8 * k + 2], p1[8 * k + 3]), cvtpk(p1[8 * k + 4], p1[8 * k + 5]), cvtpk(p1[8 * k + 6], p1[8 * k + 7])};
    }
#pragma unroll
    for (int d0 = 0; d0 < 2; ++d0) {
        s16x4 lo[4], hi[4];
#pragma unroll
        for (int ks = 0; ks < 4; ++ks) {
            asm volatile("ds_read_b64_tr_b16 %0,%1 offset:%c2" : "=&v"(lo[ks]) : "v"(vb), "i"(d0 * 4096 + ks * 1024) : "memory");
            asm volatile("ds_read_b64_tr_b16 %0,%1 offset:%c2" : "=&v"(hi[ks]) : "v"(vb), "i"(d0 * 4096 + ks * 1024 + 512) : "memory");
        }
        asm volatile("s_waitcnt lgkmcnt(0)" ::: "memory"); __builtin_amdgcn_sched_barrier(0);
#pragma unroll
        for (int ks = 0; ks < 4; ++ks) {
            const bf16x8 vf = (bf16x8){lo[ks][0], lo[ks][1], lo[ks][2], lo[ks][3], hi[ks][0], hi[ks][1], hi[ks][2], hi[ks][3]};
            o[d0] = __builtin_amdgcn_mfma_f32_32x32x16_bf16(__builtin_bit_cast(bf16x8, pw[ks]), vf, o[d0], 0, 0, 0);
        }
    }
}
__device__ __forceinline__ int pv_base(lptr Vs, int lane, int hi) { return (int)(unsigned)(uintptr_t)Vs + ((lane >> 4) & 1) * 32 + (lane & 3) * 8 + (4 * hi + ((lane & 15) >> 2)) * 64; }

constexpr float RESC_THR = 8.0f;
__device__ __forceinline__ void softmax_tile(f32x16& p0, f32x16& p1, float& m, float& l, f32x16 (&o)[2], ALDS float* wsf, int r32, int hi) {
    float a = fmaxf(p0[0], p1[0]);
#pragma unroll
    for (int r = 1; r < 16; ++r) a = fmaxf(a, fmaxf(p0[r], p1[r]));
    float lo, hv; pair_vals(a, lo, hv);
    const float rm = fmaxf(lo, hv);
    if (__any(rm > m + RESC_THR)) {
        const float mn = fmaxf(m, rm);
        const float f = (mn == NEG_INF) ? 1.0f : ex2(m - mn);
        l *= f; m = mn;
        if (hi == 0) wsf[r32] = f;
        asm volatile("s_waitcnt lgkmcnt(0)" ::: "memory");
#pragma unroll
        for (int q4 = 0; q4 < 4; ++q4) {
            const f32x4 fv = *(const ALDS f32x4*)(wsf + 8 * q4 + 4 * hi);
#pragma unroll
            for (int i = 0; i < 4; ++i) { o[0][4 * q4 + i] *= fv[i]; o[1][4 * q4 + i] *= fv[i]; }
        }
        asm volatile("s_waitcnt lgkmcnt(0)" ::: "memory");
    }
    const float ms = (m == NEG_INF) ? 0.f : m;
    float s = 0.f;
#pragma unroll
    for (int r = 0; r < 16; ++r) { p0[r] = ex2(p0[r] - ms); p1[r] = ex2(p1[r] - ms); s += p0[r] + p1[r]; }
    l += s;
}

constexpr float STICK_REM_MIN = 1e-37f;
__device__ __forceinline__ void stick_tile(f32x16& p0, f32x16& p1, float& rem, int kpos0, int qpos, bool need_mask, int nvalid, int hi) {
    float be[32], qk[32];
#pragma unroll
    for (int r = 0; r < 16; ++r) {
#pragma unroll
        for (int hh = 0; hh < 2; ++hh) {
            const float z = fminf(fmaxf(hh ? p1[r] : p0[r], -100.f), 100.f);
            const float e = ex2(-z);
            float b = __builtin_amdgcn_rcpf(1.0f + e), q = e * b;
            if (need_mask) { const int kk = crow(r, hi) + 32 * hh; const bool vis = (kk < nvalid) && (kpos0 + kk < qpos); b = vis ? b : 0.f; q = vis ? q : 1.0f; }
            be[r + 16 * hh] = b; qk[r + 16 * hh] = q;
        }
    }
    float ev[8], od[8];
#pragma unroll
    for (int j = 0; j < 8; ++j) { const float bp = (qk[4 * j] * qk[4 * j + 1]) * (qk[4 * j + 2] * qk[4 * j + 3]); pair_vals(bp, ev[j], od[j]); }
    float S = rem, mine[8];
#pragma unroll
    for (int j = 7; j >= 0; --j) { const float so = S; S *= od[j]; const float se = S; S *= ev[j]; mine[j] = hi ? so : se; }
#pragma unroll
    for (int j = 0; j < 8; ++j) {
        const float a3 = mine[j], a2 = a3 * qk[4 * j + 3], a1 = a2 * qk[4 * j + 2], a0 = a1 * qk[4 * j + 1];
        const float w0 = be[4 * j] * a0, w1 = be[4 * j + 1] * a1, w2 = be[4 * j + 2] * a2, w3 = be[4 * j + 3] * a3;
        if (j < 4) { p0[4 * j] = w0; p0[4 * j + 1] = w1; p0[4 * j + 2] = w2; p0[4 * j + 3] = w3; }
        else { p1[4 * j - 16] = w0; p1[4 * j - 15] = w1; p1[4 * j - 14] = w2; p1[4 * j - 13] = w3; }
    }
    rem = S;
}

__device__ __forceinline__ void store_o(const f32x16 (&o)[2], float inv  , ALDS float* wsf, ALDS bf16* stg, bf16* Orow0  , int nrows, int lane, int r32, int hi) {
    if (hi == 0) wsf[r32] = inv;
    asm volatile("s_waitcnt lgkmcnt(0)" ::: "memory");
    float rli[16];
#pragma unroll
    for (int q4 = 0; q4 < 4; ++q4) { const f32x4 fv = *(const ALDS f32x4*)(wsf + 8 * q4 + 4 * hi);
#pragma unroll
        for (int i = 0; i < 4; ++i) rli[4 * q4 + i] = fv[i]; }
#pragma unroll
    for (int r = 0; r < 16; ++r) { const int orow = crow(r, hi);
#pragma unroll
        for (int d0 = 0; d0 < 2; ++d0) stg[orow * 64 + d0 * 32 + r32] = (bf16)(cvtpk(o[d0][r] * rli[r], 0.f) & 0xffffu); }
    asm volatile("s_waitcnt lgkmcnt(0)" ::: "memory");
#pragma unroll
    for (int i = 0; i < 4; ++i) { const int row = i * 8 + (lane >> 3), ch = lane & 7; const u32x4 v = *(const ALDS u32x4*)(stg + row * 64 + ch * 8);
        if (row < nrows) *(u32x4*)(Orow0 + (size_t)row * DM + ch * 8) = v; }
    asm volatile("s_waitcnt lgkmcnt(0)" ::: "memory");
}

constexpr int SLOT_K = 0, SLOT_V = 8192, SLOT_B = 16384, SLOT_BYTES = 17408;
constexpr int L_WSF = 3 * SLOT_BYTES, L_OST = L_WSF + 2048, L_TAB = L_OST + 8 * 4096, L_PROMPT_END = L_TAB + 1280;
constexpr int SW_BYTES = 8192 + 8192 + 256 + 256, SW_K = 0, SW_V = 8192, SW_BIAS = 16384, SW_WSF = 16640;
constexpr int ATT_LDS_BYTES = 8 * SW_BYTES;
static_assert(L_PROMPT_END <= ATT_LDS_BYTES, "attention LDS map");

__device__ __forceinline__ void qkt_bias(f32x16& p0, f32x16& p1, lptr Bs, int r32, int hi) {
    const s16x4 k0 = *(const ALDS s16x4*)(Bs + r32 * 16 + hi * 8), k1 = *(const ALDS s16x4*)(Bs + (r32 + 32) * 16 + hi * 8);
    const short one = hi ? (short)0 : (short)0x3F80;
    const s16x4 ones = (s16x4){one, one, one, (short)0};
    p0 = __builtin_amdgcn_mfma_f32_32x32x8bf16_1k(k0, ones, p0, 0, 0, 0);
    p1 = __builtin_amdgcn_mfma_f32_32x32x8bf16_1k(k1, ones, p1, 0, 0, 0);
}
__device__ __forceinline__ float bf_round(float x) { return __uint_as_float(cvtpk(x, 0.f) << 16); }

template <int MODE>
__device__ __forceinline__ void process_tile(f32x16& p0, f32x16& p1, int t, int qb, int w, int qpos, int wq_lo, lptr slot, const ALDS float* rel, float& m, float& l, float& cum, f32x16 (&o)[2],
                                             ALDS float* wsf, int lane, int r32, int hi) {
    if (MODE == 0) stick_tile(p0, p1, cum, 64 * t, qpos, 64 * t + 63 >= wq_lo, 64, hi);
    else {
        if (MODE == 2) {
            if (64 * t + 63 > wq_lo) {
#pragma unroll
                for (int r = 0; r < 16; ++r) { const int kp = 64 * t + crow(r, hi); if (kp > qpos) p0[r] = NEG_INF; if (kp + 32 > qpos) p1[r] = NEG_INF; }
            }
        } else {
            const int cq = 4 * qb + (w >> 1);
            if (cq - t >= 3) { const float bc = rel[256];
#pragma unroll
                for (int r = 0; r < 16; ++r) { p0[r] += bc; p1[r] += bc; } }
            else {
#pragma unroll
                for (int r = 0; r < 16; ++r) { const int d0_ = qpos - (64 * t + crow(r, hi)); int i0 = d0_ < -128 ? -128 : (d0_ > 128 ? 128 : d0_); int i1 = d0_ - 32 < -128 ? -128 : (d0_ - 32 > 128 ? 128 : d0_ - 32);
                    p0[r] += rel[i0 + 128]; p1[r] += rel[i1 + 128]; }
            }
        }
        softmax_tile(p0, p1, m, l, o, wsf, r32, hi);
    }
    pv(o, pv_base(slot + SLOT_V, lane, hi), p0, p1);
}

template <int MODE>
__device__ __forceinline__ void prompt_unit(int hcol, int qb, const bf16* Qg, const bf16* Kg, const bf16* Vg, bf16* Og, lptr lds, const double* Dh, const float* rel, int tid_in, int t_first = 0) {
    int tid_ = tid_in; asm volatile("" : "+v"(tid_));
    const int tid = tid_, lane = tid & 63, r32 = lane & 31, hi = lane >> 5, w = __builtin_amdgcn_readfirstlane(tid >> 6);
    const int q0 = qb * 256, wq_lo = q0 + 32 * w, wq_hi = wq_lo + 31, qpos = wq_lo + r32;
    ALDS float* wsf = (ALDS float*)(lds + L_WSF) + w * 64; ALDS bf16* stg = (ALDS bf16*)(lds + L_OST + w * 4096);
    bf16x8 qr[4];
#pragma unroll
    for (int d0 = 0; d0 < 4; ++d0) qr[d0] = *(const bf16x8*)(Qg + (size_t)qpos * DM + hcol * 64 + 16 * d0 + 8 * hi);
    ALDS float* tabl = (ALDS float*)(lds + L_TAB);
    if (MODE == 1) { for (int i = tid; i < 257; i += 512) tabl[i] = rel[i] * LOG2E; }
    f32x16 o[2]; o[0] = f32x16{}; o[1] = f32x16{};
    float m = NEG_INF, l = 0.f, cum = 1.0f;
    int t0, n, step;
    if (MODE == 0) { t0 = 4 * qb + 3; n = 4 * qb + 4; step = -1; }
    else if (MODE == 2) { t0 = 4 * qb + 3; n = 4 * qb + 4 - t_first; step = -1; }
    else { t0 = 4 * qb - 8; if (t0 < 0) t0 = 0; n = 4 * qb + 4 - t0; step = 1; }
    double dref = 0.0, dk = 0.0;
    if (MODE == 2) dref = Dh[q0 + 255];
    const bf16* kbase = Kg + (size_t)lane * DM + hcol * 64 + w * 8;
    const bf16* vbase = Vg + (size_t)(16 * (w & 3) + (lane >> 2)) * DM + hcol * 64 + 32 * (w >> 2) + 8 * (lane & 3);
    u32x4 kr, vr;
#define LOADREGS(tt) do { const size_t off_ = (size_t)(tt) * 64 * DM; kr = *(const u32x4*)(kbase + off_); vr = *(const u32x4*)(vbase + off_); if (MODE == 2) dk = Dh[(tt) * 64 + lane]; } while (0)
#define WRITESLOT(sl) do { *(ALDS u32x4*)((sl) + SLOT_K + w * 1024 + lane * 16) = kr; *(ALDS u32x4*)((sl) + SLOT_V + w * 1024 + lane * 16) = vr; \
        if (MODE == 2 && w == 0) { const float b_ = (float)(dref - dk) * LOG2E; const float h_ = bf_round(b_); const float r1_ = b_ - h_; const float m_ = bf_round(r1_); const float l_ = r1_ - m_; \
            *(ALDS u32x4*)((sl) + SLOT_B + lane * 16) = (u32x4){cvtpk(h_, m_), cvtpk(l_, 0.f), 0u, 0u}; } } while (0)
#define ACTIVE(tt) ((MODE == 0) ? (64 * (tt) < wq_hi) : (MODE == 2) ? (64 * (tt) <= wq_hi) : (((tt) >= 4 * qb + (w >> 1) - 8) && ((tt) <= 4 * qb + (w >> 1))))
    lptr s_cur = lds, s_nxt = lds + SLOT_BYTES, s_wr = lds + 2 * SLOT_BYTES;
    LOADREGS(t0); WRITESLOT(s_cur);
    if (n > 1) LOADREGS(t0 + step);
    __syncthreads();
    if (n > 1) WRITESLOT(s_nxt);
    if (n > 2) LOADREGS(t0 + 2 * step);
    f32x16 c0, c1, n0, n1;
    if (ACTIVE(t0)) { qkt(c0, c1, s_cur + SLOT_K, qr, r32, hi); if (MODE == 2) qkt_bias(c0, c1, s_cur + SLOT_B, r32, hi); }
    __syncthreads();
    for (int i = 0;; ++i) {
        const int t = t0 + i * step;
        if (i + 2 < n) { WRITESLOT(s_wr); if (i + 3 < n) LOADREGS(t + 3 * step); }
        const bool act = ACTIVE(t), actn = (i + 1 < n) && ACTIVE(t + step);
        if (act && actn) {
            qkt(n0, n1, s_nxt + SLOT_K, qr, r32, hi); if (MODE == 2) qkt_bias(n0, n1, s_nxt + SLOT_B, r32, hi);
            process_tile<MODE>(c0, c1, t, qb, w, qpos, wq_lo, s_cur, tabl, m, l, cum, o, wsf, lane, r32, hi);
        } else {
            if (actn) { qkt(n0, n1, s_nxt + SLOT_K, qr, r32, hi); if (MODE == 2) qkt_bias(n0, n1, s_nxt + SLOT_B, r32, hi); }
            if (act) process_tile<MODE>(c0, c1, t, qb, w, qpos, wq_lo, s_cur, tabl, m, l, cum, o, wsf, lane, r32, hi);
        }
        const int all = __syncthreads_and(MODE == 0 ? (cum < STICK_REM_MIN ? 1 : 0) : 0);
        if (i + 1 >= n || all) break;
        c0 = n0; c1 = n1;
        const lptr tmp = s_cur; s_cur = s_nxt; s_nxt = s_wr; s_wr = tmp;
    }
#undef LOADREGS
#undef WRITESLOT
#undef ACTIVE
    float inv = 1.0f;
    if (MODE != 0) { float lo, hv; pair_vals(l, lo, hv); inv = 1.0f / (lo + hv); }
    store_o(o, inv, wsf, stg, Og + (size_t)wq_lo * DM + hcol * 64, 32, lane, r32, hi);
    __syncthreads();
}

struct SmpSrc { const float* ck; const float* cv; int L, H, hl; const bf16* Kn; const bf16* Vn; };
#ifndef STAGE_BOTH_MASK
#define STAGE_BOTH_MASK 0
#endif
template <bool BOTH = false>
__device__ __forceinline__ void stage_cache_tile(const SmpSrc& S, int tt, lptr Ks, lptr Vs, int lane_in) {
    int lane = lane_in; asm volatile("" : "+v"(lane));
    const size_t rs = (size_t)S.H * 64; const int piece = lane & 15, rsub = lane >> 4;
    size_t eoff = ((size_t)tt * 64 * S.H + S.hl) * 64 + (size_t)rsub * rs + 4 * piece;
    asm volatile("" : "+v"(eoff));
    const float* kp = S.ck + eoff; const float* vp = S.cv + eoff;
    if (BOTH) {
        f32x4 x[16], y[16];
#pragma unroll
        for (int i = 0; i < 16; ++i) x[i] = __builtin_nontemporal_load((const f32x4*)(kp + (size_t)(4 * i) * rs));
#pragma unroll
        for (int i = 0; i < 16; ++i) y[i] = __builtin_nontemporal_load((const f32x4*)(vp + (size_t)(4 * i) * rs));
#pragma unroll
        for (int i = 0; i < 16; ++i) { const int row = 4 * i + rsub; *(ALDS u32x2*)(Ks + (piece >> 1) * 1024 + row * 16 + (piece & 1) * 8) = (u32x2){cvtpk(x[i][0], x[i][1]), cvtpk(x[i][2], x[i][3])}; }
#pragma unroll
        for (int i = 0; i < 16; ++i) { const int row = 4 * i + rsub, d = 4 * piece;
            *(ALDS u32x2*)(Vs + (d >> 5) * 4096 + (row >> 4) * 1024 + (row & 15) * 64 + (d & 31) * 2) = (u32x2){cvtpk(y[i][0], y[i][1]), cvtpk(y[i][2], y[i][3])}; }
        return;
    }
    f32x4 x[16];
#pragma unroll
    for (int i = 0; i < 16; ++i) x[i] = __builtin_nontemporal_load((const f32x4*)(kp + (size_t)(4 * i) * rs));
#pragma unroll
    for (int i = 0; i < 16; ++i) { const int row = 4 * i + rsub; *(ALDS u32x2*)(Ks + (piece >> 1) * 1024 + row * 16 + (piece & 1) * 8) = (u32x2){cvtpk(x[i][0], x[i][1]), cvtpk(x[i][2], x[i][3])}; }
#pragma unroll
    for (int i = 0; i < 16; ++i) x[i] = __builtin_nontemporal_load((const f32x4*)(vp + (size_t)(4 * i) * rs));
#pragma unroll
    for (int i = 0; i < 16; ++i) { const int row = 4 * i + rsub, d = 4 * piece;
        *(ALDS u32x2*)(Vs + (d >> 5) * 4096 + (row >> 4) * 1024 + (row & 15) * 64 + (d & 31) * 2) = (u32x2){cvtpk(x[i][0], x[i][1]), cvtpk(x[i][2], x[i][3])}; }
}
__device__ __forceinline__ void stage_bf16_tile(const bf16* Kn, const bf16* Vn, int nrows, lptr Ks, lptr Vs, int lane_in) {
    int lane = lane_in; asm volatile("" : "+v"(lane));
    const int piece = lane & 7, rsub = lane >> 3;
#pragma unroll
    for (int i = 0; i < 8; ++i) { const int row = 8 * i + rsub, d = 8 * piece;
        u32x4 kx = (u32x4){0u, 0u, 0u, 0u}, vx = kx;
        if (row < nrows) { kx = *(const u32x4*)(Kn + (size_t)row * DM + d); vx = *(const u32x4*)(Vn + (size_t)row * DM + d); }
        *(ALDS u32x4*)(Ks + piece * 1024 + row * 16) = kx;
        *(ALDS u32x4*)(Vs + (d >> 5) * 4096 + (row >> 4) * 1024 + (row & 15) * 64 + (d & 31) * 2) = vx; }
}
__device__ __forceinline__ void load_bf16_tile(const bf16* Kn, const bf16* Vn, u32x4 (&kx)[8], u32x4 (&vx)[8], int lane_in) {
    int lane = lane_in; asm volatile("" : "+v"(lane));
    const int piece = lane & 7, rsub = lane >> 3;
#pragma unroll
    for (int i = 0; i < 8; ++i) { const size_t off = (size_t)(8 * i + rsub) * DM + 8 * piece; kx[i] = *(const u32x4*)(Kn + off); vx[i] = *(const u32x4*)(Vn + off); }
}
__device__ __forceinline__ void write_bf16_tile(const u32x4 (&kx)[8], const u32x4 (&vx)[8], lptr Ks, lptr Vs, int lane_in) {
    int lane = lane_in; asm volatile("" : "+v"(lane));
    const int piece = lane & 7, rsub = lane >> 3;
#pragma unroll
    for (int i = 0; i < 8; ++i) { const int row = 8 * i + rsub, d = 8 * piece;
        *(ALDS u32x4*)(Ks + piece * 1024 + row * 16) = kx[i];
        *(ALDS u32x4*)(Vs + (d >> 5) * 4096 + (row >> 4) * 1024 + (row & 15) * 64 + (d & 31) * 2) = vx[i]; }
}
__device__ __forceinline__ void stick_wave_unit(int hcol, int q32, const bf16* Qg, const bf16* Kg, const bf16* Vg, bf16* Og, lptr wl, int lane_in) {
    int lane = lane_in; asm volatile("" : "+v"(lane));
    const int r32 = lane & 31, hi = lane >> 5, q_lo = 32 * q32, qpos = q_lo + r32;
    const lptr Ks = wl + SW_K, Vs = wl + SW_V; const int vb = pv_base(Vs, lane, hi);
    const bf16* Kh = Kg + hcol * 64; const bf16* Vh = Vg + hcol * 64;
    bf16x8 qr[4];
#pragma unroll
    for (int d0 = 0; d0 < 4; ++d0) qr[d0] = *(const bf16x8*)(Qg + (size_t)qpos * DM + hcol * 64 + 16 * d0 + 8 * hi);
    f32x16 o[2]; o[0] = f32x16{}; o[1] = f32x16{}; float cum = 1.0f;
    u32x4 kx[8], vx[8];
    int t = (q_lo + 30) >> 6;
    load_bf16_tile(Kh + (size_t)t * 64 * DM, Vh + (size_t)t * 64 * DM, kx, vx, lane);
    for (; t >= 0; --t) {
        write_bf16_tile(kx, vx, Ks, Vs, lane);
        if (t > 0) load_bf16_tile(Kh + (size_t)(t - 1) * 64 * DM, Vh + (size_t)(t - 1) * 64 * DM, kx, vx, lane);
        asm volatile("s_waitcnt lgkmcnt(0)" ::: "memory");
        f32x16 p0, p1; qkt(p0, p1, Ks, qr, r32, hi);
        stick_tile(p0, p1, cum, 64 * t, qpos, 64 * t + 63 >= q_lo, 64, hi);
        pv(o, vb, p0, p1);
        asm volatile("s_waitcnt lgkmcnt(0)" ::: "memory");
        if (__all(cum < STICK_REM_MIN)) break;
    }
    store_o(o, 1.0f, (ALDS float*)(wl + SW_WSF), (ALDS bf16*)(wl + SW_K), Og + (size_t)q_lo * DM + hcol * 64, 32, lane, r32, hi);
}

__device__ __forceinline__ void band_wave_unit(int hcol, int q32, const bf16* Qg, const bf16* Kg, const bf16* Vg, bf16* Og, lptr wl, const ALDS float* tab, int lane_in) {
    int lane = lane_in; asm volatile("" : "+v"(lane));
    const int r32 = lane & 31, hi = lane >> 5, q_lo = 32 * q32, chunk = q32 >> 1;
    const lptr Ks = wl + SW_K, Vs = wl + SW_V; const int vb = pv_base(Vs, lane, hi); ALDS float* wsf = (ALDS float*)(wl + SW_WSF);
    const bf16* Kh = Kg + hcol * 64; const bf16* Vh = Vg + hcol * 64;
    bf16x8 qr[4];
#pragma unroll
    for (int d0 = 0; d0 < 4; ++d0) qr[d0] = *(const bf16x8*)(Qg + (size_t)(q_lo + r32) * DM + hcol * 64 + 16 * d0 + 8 * hi);
    f32x16 o[2]; o[0] = f32x16{}; o[1] = f32x16{}; float m = NEG_INF, l = 0.f;
    u32x4 kx[8], vx[8];
    int t = chunk - 8; if (t < 0) t = 0;
    load_bf16_tile(Kh + (size_t)t * 64 * DM, Vh + (size_t)t * 64 * DM, kx, vx, lane);
    const float bc = tab[256];
    for (; t <= chunk; ++t) {
        write_bf16_tile(kx, vx, Ks, Vs, lane);
        if (t < chunk) load_bf16_tile(Kh + (size_t)(t + 1) * 64 * DM, Vh + (size_t)(t + 1) * 64 * DM, kx, vx, lane);
        asm volatile("s_waitcnt lgkmcnt(0)" ::: "memory");
        f32x16 p0, p1; qkt(p0, p1, Ks, qr, r32, hi);
        if (chunk - t >= 3) {
#pragma unroll
            for (int r = 0; r < 16; ++r) { p0[r] += bc; p1[r] += bc; }
        } else {
            const int dq = q_lo + r32 - 64 * t;
#pragma unroll
            for (int r = 0; r < 16; ++r) { const int d0_ = dq - crow(r, hi); int i0 = d0_ < -128 ? -128 : (d0_ > 128 ? 128 : d0_); int i1 = d0_ - 32 < -128 ? -128 : (d0_ - 32 > 128 ? 128 : d0_ - 32);
                p0[r] += tab[i0 + 128]; p1[r] += tab[i1 + 128]; }
        }
        softmax_tile(p0, p1, m, l, o, wsf, r32, hi);
        pv(o, vb, p0, p1);
        asm volatile("s_waitcnt lgkmcnt(0)" ::: "memory");
    }
    float lo, hv; pair_vals(l, lo, hv);
    store_o(o, 1.0f / (lo + hv), wsf, (ALDS bf16*)(wl + SW_K), Og + (size_t)q_lo * DM + hcol * 64, 32, lane, r32, hi);
}

template <int MODE>
__device__ __forceinline__ void sample_walk(const SmpSrc& S, int t0, int step, int cnt, const bf16x8 (&qr)[4], lptr wl, const double* Db, const float* rel,
                                            f32x16 (&o)[2], float& m, float& l, float& cum, int lane, int r32, int hi) {
    const lptr Ks = wl + SW_K, Vs = wl + SW_V; ALDS float* biasl = (ALDS float*)(wl + SW_BIAS); ALDS float* wsf = (ALDS float*)(wl + SW_WSF);
    const int vb = pv_base(Vs, lane, hi); const int qpos = PAST + (r32 & 15); const int nct = S.L >> 6;
    double dref = 0.0; if (MODE == 2) dref = Db[S.L + 15];
    int t = t0;
    for (int it = 0; it < cnt; ++it, t += step) {
        int nvalid;
        if (t >= nct) { stage_bf16_tile(S.Kn, S.Vn, 16, Ks, Vs, lane); nvalid = 16; } else { stage_cache_tile<(STAGE_BOTH_MASK >> MODE) & 1>(S, t, Ks, Vs, lane); nvalid = 64; }
        const int kpos0 = (PAST - S.L) + 64 * t;
        if (MODE == 2) biasl[lane] = (lane < nvalid) ? (float)(dref - Db[64 * t + lane]) * LOG2E : 0.f;
        asm volatile("s_waitcnt lgkmcnt(0)" ::: "memory");
        const bool need_mask = (t >= nct);
        f32x16 p0, p1; qkt(p0, p1, Ks, qr, r32, hi);
        if (MODE == 0) stick_tile(p0, p1, cum, kpos0, qpos, need_mask, nvalid, hi);
        else {
            if (MODE == 2) {
#pragma unroll
                for (int q4 = 0; q4 < 4; ++q4) { const f32x4 b0 = *(const ALDS f32x4*)(biasl + 8 * q4 + 4 * hi), b1 = *(const ALDS f32x4*)(biasl + 32 + 8 * q4 + 4 * hi);
#pragma unroll
                    for (int i = 0; i < 4; ++i) { p0[4 * q4 + i] += b0[i]; p1[4 * q4 + i] += b1[i]; } }
            } else {
#pragma unroll
                for (int r = 0; r < 16; ++r) { const int d0_ = qpos - (kpos0 + crow(r, hi)); int i0 = d0_ < -128 ? -128 : (d0_ > 128 ? 128 : d0_); int i1 = d0_ - 32 < -128 ? -128 : (d0_ - 32 > 128 ? 128 : d0_ - 32);
                    p0[r] += rel[i0 + 128] * LOG2E; p1[r] += rel[i1 + 128] * LOG2E; }
            }
            if (need_mask) {
#pragma unroll
                for (int r = 0; r < 16; ++r) { const int kk = crow(r, hi); const bool v0 = (kk < nvalid) && (MODE == 1 || kpos0 + kk <= qpos); const bool v1 = (kk + 32 < nvalid) && (MODE == 1 || kpos0 + kk + 32 <= qpos);
                    if (!v0) p0[r] = NEG_INF; if (!v1) p1[r] = NEG_INF; }
            }
            softmax_tile(p0, p1, m, l, o, wsf, r32, hi);
        }
        pv(o, vb, p0, p1);
        asm volatile("s_waitcnt lgkmcnt(0)" ::: "memory");
        if (MODE == 0 && __all(cum < STICK_REM_MIN)) break;
    }
}
__device__ __forceinline__ void load_q_sample(bf16x8 (&qr)[4], const bf16* Qg, int b, int hcol, int r32, int hi) {
#pragma unroll
    for (int d0 = 0; d0 < 4; ++d0) qr[d0] = *(const bf16x8*)(Qg + (size_t)(SEQ + b * 16 + (r32 & 15)) * DM + hcol * 64 + 16 * d0 + 8 * hi);
}
template <int MODE>
__device__ __forceinline__ void sample_unit_wave(const SmpSrc& S, int b, int hcol, const bf16* Qg, bf16* Og, lptr wl, const float* rel, int lane) {
    const int r32 = lane & 31, hi = lane >> 5; const int nt = (S.L >> 6) + 1;
    bf16x8 qr[4]; load_q_sample(qr, Qg, b, hcol, r32, hi);
    f32x16 o[2]; o[0] = f32x16{}; o[1] = f32x16{}; float m = NEG_INF, l = 0.f, cum = 1.0f;
    if (MODE == 0) sample_walk<0>(S, nt - 1, -1, nt, qr, wl, nullptr, rel, o, m, l, cum, lane, r32, hi);
    else sample_walk<1>(S, 0, 1, nt, qr, wl, nullptr, rel, o, m, l, cum, lane, r32, hi);
    float inv = 1.0f;
    if (MODE != 0) { float lo, hv; pair_vals(l, lo, hv); inv = 1.0f / (lo + hv); }
    store_o(o, inv, (ALDS float*)(wl + SW_WSF), (ALDS bf16*)(wl + SW_K), Og + (size_t)(SEQ + b * 16) * DM + hcol * 64, 16, lane, r32, hi);
}
__device__ __forceinline__ void sample_unit_stick_pre(const SmpSrc& S, int b, int hcol, const bf16* Qg, bf16* Og, lptr lds, int wave, int lane) {
    const int nct = S.L >> 6;
    if (wave == 0) stage_bf16_tile(S.Kn, S.Vn, 16, lds + SW_K, lds + SW_V, lane);
    else stage_cache_tile(S, nct - wave, lds + wave * SW_BYTES + SW_K, lds + wave * SW_BYTES + SW_V, lane);
    asm volatile("s_waitcnt lgkmcnt(0)" ::: "memory");
    __syncthreads();
    if (wave == 0) {
        const int r32 = lane & 31, hi = lane >> 5; const int qpos = PAST + (r32 & 15);
        bf16x8 qr[4]; load_q_sample(qr, Qg, b, hcol, r32, hi);
        f32x16 o[2]; o[0] = f32x16{}; o[1] = f32x16{}; float cum = 1.0f;
        for (int it = 0; it <= nct; ++it) {
            const int t = nct - it; int reg = (it <= 7) ? it : 0; asm volatile("" : "+s"(reg));
            const lptr Ks = lds + reg * SW_BYTES + SW_K, Vs = lds + reg * SW_BYTES + SW_V;
            if (it > 7) { stage_cache_tile(S, t, Ks, Vs, lane); asm volatile("s_waitcnt lgkmcnt(0)" ::: "memory"); }
            const int kpos0 = (PAST - S.L) + 64 * t;
            f32x16 p0, p1; qkt(p0, p1, Ks, qr, r32, hi);
            stick_tile(p0, p1, cum, kpos0, qpos, it == 0, it == 0 ? 16 : 64, hi);
            pv(o, pv_base(Vs, lane, hi), p0, p1);
            asm volatile("s_waitcnt lgkmcnt(0)" ::: "memory");
            if (__all(cum < STICK_REM_MIN)) break;
        }
        store_o(o, 1.0f, (ALDS float*)(lds + SW_WSF), (ALDS bf16*)(lds + SW_K), Og + (size_t)(SEQ + b * 16) * DM + hcol * 64, 16, lane, r32, hi);
    }
}
template <int MODE>
__device__ __forceinline__ void sample_unit_split(const SmpSrc& S, int b, int hcol, const bf16* Qg, bf16* Og, lptr lds, const double* Db, const float* rel, int tid_in) {
    int tid_ = tid_in; asm volatile("" : "+v"(tid_));
    const int tid = tid_, lane = tid & 63, r32 = lane & 31, hi = lane >> 5, w = __builtin_amdgcn_readfirstlane(tid >> 6);
    const lptr wl = lds + w * SW_BYTES;
    const int nt = (S.L >> 6) + 1, per = nt >> 3;
    bf16x8 qr[4]; load_q_sample(qr, Qg, b, hcol, r32, hi);
    f32x16 o[2]; o[0] = f32x16{}; o[1] = f32x16{}; float m = NEG_INF, l = 0.f, cum = 1.0f;
    sample_walk<MODE>(S, per * w, 1, (w == 7) ? nt - 7 * per : per, qr, wl, Db, rel, o, m, l, cum, lane, r32, hi);
    ALDS float* pm = (ALDS float*)wl; ALDS float* pl = pm + 16; ALDS float* po = pm + 32;
    { float lo, hv; pair_vals(l, lo, hv); if (lane < 16) { pm[lane] = m; pl[lane] = lo + hv; } }
#pragma unroll
    for (int r = 0; r < 8; ++r) { const int q = crow(r, hi);
#pragma unroll
        for (int d0 = 0; d0 < 2; ++d0) po[q * 64 + d0 * 32 + r32] = o[d0][r]; }
    __syncthreads();
    { const int q = tid >> 5, d = (tid & 31) * 2;
      float M = NEG_INF;
#pragma unroll
      for (int ww = 0; ww < 8; ++ww) M = fmaxf(M, ((ALDS float*)(lds + ww * SW_BYTES))[q]);
      float den = 0.f, n0 = 0.f, n1 = 0.f;
#pragma unroll
      for (int ww = 0; ww < 8; ++ww) { ALDS float* base = (ALDS float*)(lds + ww * SW_BYTES); const float f = ex2(base[q] - M); den += base[16 + q] * f; n0 += base[32 + q * 64 + d] * f; n1 += base[32 + q * 64 + d + 1] * f; }
      const float inv = 1.0f / den;
      *(unsigned*)(Og + (size_t)(SEQ + b * 16 + q) * DM + hcol * 64 + d) = cvtpk(n0 * inv, n1 * inv); }
    __syncthreads();
}
}

#ifndef FORGET_SHFL_SCAN
#define FORGET_SHFL_SCAN 0
#endif
namespace smm {
using att::bf16; using att::bf16x8; using att::f32x16; using att::f32x4; using att::u32x4; using att::lptr; using att::crow;
typedef pg8::bf16_t bf16_t;
typedef float f32x4v __attribute__((ext_vector_type(4)));
template <int CH>
__device__ __forceinline__ void kload(bf16x8 (&af)[CH][2], bf16x8 (&bf)[CH][2], const bf16* A0, size_t lda, const bf16* B0, const bf16* B1, int kc) {
#pragma unroll
    for (int s = 0; s < CH; ++s) {
        af[s][0] = *(const bf16x8*)(A0 + kc + 16 * s); af[s][1] = *(const bf16x8*)(A0 + 32 * lda + kc + 16 * s);
        bf[s][0] = *(const bf16x8*)(B0 + kc + 16 * s); bf[s][1] = *(const bf16x8*)(B1 + kc + 16 * s);
    }
}
template <int CH>
__device__ __forceinline__ void kmma(f32x16 (&acc)[2][2], const bf16x8 (&af)[CH][2], const bf16x8 (&bf)[CH][2]) {
#pragma unroll
    for (int s = 0; s < CH; ++s)
#pragma unroll
        for (int i = 0; i < 2; ++i)
#pragma unroll
            for (int j = 0; j < 2; ++j) acc[i][j] = __builtin_amdgcn_mfma_f32_32x32x16_bf16(af[s][i], bf[s][j], acc[i][j], 0, 0, 0);
}
template <int CH>
__device__ __forceinline__ void kloop(f32x16 (&acc)[2][2], const bf16* A0, size_t lda, const bf16* B0, const bf16* B1, int k0, int klen) {
    bf16x8 a0[CH][2], b0[CH][2], a1[CH][2], b1[CH][2];
    const int kend = k0 + klen;
    kload<CH>(a0, b0, A0, lda, B0, B1, k0);
    for (int kc = k0; kc < kend; kc += 32 * CH) {
        if (kc + 16 * CH < kend) kload<CH>(a1, b1, A0, lda, B0, B1, kc + 16 * CH);
        kmma<CH>(acc, a0, b0);
        if (kc + 16 * CH < kend) {
            if (kc + 32 * CH < kend) kload<CH>(a0, b0, A0, lda, B0, B1, kc + 32 * CH);
            kmma<CH>(acc, a1, b1);
        }
    }
}
__device__ __forceinline__ void reduce8(const f32x16 (&acc)[2][2], lptr lds, int tid, int w, int r32, int hi, float (&v)[8]) {
    ALDS float* part = (ALDS float*)lds + w * 4096;
#pragma unroll
    for (int i = 0; i < 2; ++i)
#pragma unroll
        for (int j = 0; j < 2; ++j)
#pragma unroll
            for (int r = 0; r < 16; ++r) part[(32 * i + crow(r, hi)) * 64 + 32 * j + r32] = acc[i][j][r];
    __syncthreads();
    const int row = tid >> 3, cg = tid & 7;
    f32x4 s0 = (f32x4){0.f, 0.f, 0.f, 0.f}, s1 = s0;
#pragma unroll
    for (int ww = 0; ww < 8; ++ww) { const ALDS float* p = (const ALDS float*)lds + ww * 4096 + row * 64 + 8 * cg; s0 += *(const ALDS f32x4*)p; s1 += *(const ALDS f32x4*)(p + 4); }
    __syncthreads();
#pragma unroll
    for (int i = 0; i < 4; ++i) { v[i] = s0[i]; v[4 + i] = s1[i]; }
}
__device__ __forceinline__ float sum8sq(const float (&v)[8]) { return ((v[0] * v[0] + v[1] * v[1]) + (v[2] * v[2] + v[3] * v[3])) + ((v[4] * v[4] + v[5] * v[5]) + (v[6] * v[6] + v[7] * v[7])); }
__device__ __forceinline__ float xor8(float s) { s += __shfl_xor(s, 1); s += __shfl_xor(s, 2); s += __shfl_xor(s, 4); return s; }
__device__ __forceinline__ u32x4 pack8v(const float (&v)[8]) { return (u32x4){pg8::cvt_pk_bf16(v[0], v[1]), pg8::cvt_pk_bf16(v[2], v[3]), pg8::cvt_pk_bf16(v[4], v[5]), pg8::cvt_pk_bf16(v[6], v[7])}; }
#define SMM_IDS int tid_ = tid_in; asm volatile("" : "+v"(tid_)); const int tid = tid_, lane = tid & 63, r32 = lane & 31, hi = lane >> 5, w = __builtin_amdgcn_readfirstlane(tid >> 6); (void)lane
#define SMM_ZERO(acc) do { _Pragma("unroll") for (int i_ = 0; i_ < 2; ++i_) _Pragma("unroll") for (int j_ = 0; j_ < 2; ++j_) acc[i_][j_] = f32x16{}; } while (0)

__device__ __forceinline__ void in_proj(const bf16* HB, const bf16* W, const float* ssq, bf16_t* Qb, float* out, const float* gq, const float* gk, const float* bfg, int odd, int j,
                                        float* LPt  , double* Tt  , lptr lds, int bx, int G, int tid_in) {
    SMM_IDS;
    const int nu = odd ? 192 + 4 + 256 : 192;
    for (int u = bx; u < nu; u += G) {
        int ct, row0;
        if (u < 192) { ct = u >> 2; row0 = SEQ + 64 * (u & 3); } else { ct = 48; const int fu = u - 192; row0 = (fu < 4) ? SEQ + 64 * fu : 64 * (fu - 4); }
        const int brow0 = (ct < 48) ? 256 * (ct >> 2) + 32 * (ct & 3) : 3072, brow1 = (ct < 48) ? brow0 + 128 : 3104;
        const int row = row0 + (tid >> 3), cg = tid & 7; const float r = pg8::row_rscale(ssq, row);
        f32x16 acc[2][2]; SMM_ZERO(acc);
        kloop<4>(acc, HB + (size_t)(row0 + r32) * DM + 8 * hi, DM, W + (size_t)(brow0 + r32) * DM + 8 * hi, W + (size_t)(brow1 + r32) * DM + 8 * hi, 128 * w, 128);
        float v[8]; reduce8(acc, lds, tid, w, r32, hi, v);
#pragma unroll
        for (int i = 0; i < 8; ++i) v[i] *= r;
        if (ct == 48) {
            float y[8];
            if (cg < 2) {
#pragma unroll
                for (int i = 0; i < 8; ++i) y[i] = pg8::log_sigmoid_f(v[i] + bfg[8 * cg + i]);
                float* dst = out + (row >= SEQ ? O_SCF + (size_t)(j * NSMP + row - SEQ) * 16 : O_PCF + ((size_t)j * SEQ + row) * 16) + 8 * cg;
                *(f32x4*)dst = (f32x4){y[0], y[1], y[2], y[3]}; *(f32x4*)(dst + 4) = (f32x4){y[4], y[5], y[6], y[7]}; }
            if (row0 < SEQ) {
                ALDS float* fl = (ALDS float*)lds;
                if (cg < 2) {
#pragma unroll
                    for (int i = 0; i < 8; ++i) fl[(8 * cg + i) * 64 + (tid >> 3)] = y[i]; }
                __syncthreads();
#if FORGET_SHFL_SCAN
#pragma unroll
                for (int hh = 0; hh < 2; ++hh) {
                    const int hd_ = 2 * w + hh; double x_ = (double)fl[hd_ * 64 + lane];
#pragma unroll
                    for (int o_ = 1; o_ < 64; o_ <<= 1) { const double t_ = __shfl_up(x_, o_); if (lane >= o_) x_ += t_; }
                    fl[hd_ * 64 + lane] = (float)x_;
                    if (lane == 63) Tt[hd_ * 256 + (row0 >> 6)] = x_; }
#else
                if (tid < 16) { double run = 0.0;
                    for (int r = 0; r < 64; ++r) { run += (double)fl[tid * 64 + r]; fl[tid * 64 + r] = (float)run; }
                    Tt[tid * 256 + (row0 >> 6)] = run; }
#endif
                __syncthreads();
                if (tid < 256) *(f32x4*)(LPt + (size_t)(tid >> 4) * SEQ + row0 + 4 * (tid & 15)) = *(const ALDS f32x4*)(fl + (tid >> 4) * 64 + 4 * (tid & 15));
                __syncthreads();
            }
            continue;
        }
        const int t = ct >> 4, hd = ct & 15;
        if ((t < 2) && (odd || hd >= 8)) {
            const float rs = pg8::rsq_f(xor8(sum8sq(v)) * (1.0f / 64.0f) + RMS_EPS); const float* g = (t == 0 ? gq : gk) + 8 * cg;
#pragma unroll
            for (int i = 0; i < 8; ++i) v[i] = v[i] * rs * g[i];
        }
        bf16_t* orow = Qb + (size_t)t * ((size_t)MROWS * DM) + (size_t)row * DM + hd * 64 + 8 * cg;
        if (t == 0) {
#pragma unroll
            for (int i = 0; i < 8; ++i) v[i] *= QSCALE;
            *(u32x4*)orow = pack8v(v);
        } else {
            *(u32x4*)orow = pack8v(v);
            float* fo = pg8::kv_dst(out, odd, j, t, hd, row) + 8 * cg;
            *(f32x4*)fo = (f32x4){v[0], v[1], v[2], v[3]}; *(f32x4*)(fo + 4) = (f32x4){v[4], v[5], v[6], v[7]};
        }
    }
}
__device__ __forceinline__ void residual(const bf16* A, const bf16* W, int kdim, const bf16_t* hb_in, bf16_t* hb_out, float* ssq, lptr lds, int bx, int G, int tid_in) {
    SMM_IDS;
    for (int u = bx; u < 64; u += G) {
        const int rb = u & 3, ct = u >> 2, row0 = SEQ + 64 * rb, c0 = 64 * ct;
        f32x16 acc[2][2]; SMM_ZERO(acc);
        kloop<4>(acc, A + (size_t)(row0 + r32) * kdim + 8 * hi, (size_t)kdim, W + (size_t)(c0 + r32) * kdim + 8 * hi, W + (size_t)(c0 + 32 + r32) * kdim + 8 * hi, (kdim >> 3) * w, kdim >> 3);
        float v[8]; reduce8(acc, lds, tid, w, r32, hi, v);
        const int row = row0 + (tid >> 3), cg = tid & 7; const size_t off = (size_t)row * DM + c0 + 8 * cg;
        f32x4 h0, h1; pg8::unpack8(*(const u32x4*)(hb_in + off), h0, h1);
#pragma unroll
        for (int i = 0; i < 4; ++i) { v[i] += h0[i]; v[4 + i] += h1[i]; }
        *(u32x4*)(hb_out + off) = pack8v(v);
        const float s = xor8(sum8sq(v));
        if (cg == 0) ssq[(size_t)row * 16 + ct] = s;
    }
}
__device__ __forceinline__ void ff1(const bf16* HB, const bf16* W, const float* ssq, bf16_t* hid, lptr lds, int bx, int G, int tid_in) {
    SMM_IDS;
    for (int u = bx; u < 256; u += G) {
        const int rb = u & 3, ct = u >> 2, row0 = SEQ + 64 * rb, c0 = 64 * ct;
        const int row = row0 + (tid >> 3), cg = tid & 7; const float r = pg8::row_rscale(ssq, row);
        f32x16 acc[2][2]; SMM_ZERO(acc);
        kloop<4>(acc, HB + (size_t)(row0 + r32) * DM + 8 * hi, DM, W + (size_t)(c0 + r32) * DM + 8 * hi, W + (size_t)(c0 + 32 + r32) * DM + 8 * hi, 128 * w, 128);
        float v[8]; reduce8(acc, lds, tid, w, r32, hi, v);
#pragma unroll
        for (int i = 0; i < 8; ++i) { const float x = fmaxf(v[i] * r, 0.f); v[i] = x * x; }
        *(u32x4*)(hid + (size_t)row * FF + c0 + 8 * cg) = pack8v(v);
    }
}
__device__ __forceinline__ void ple(const bf16* HB, const bf16* Wg, const bf16* PB, const bf16* Wp, const float* ssq_in, bf16_t* hb, float* ssq_out, float* yout  ,
                                    lptr lds, int bx, int G, int tid_in) {
    SMM_IDS;
    for (int u = bx; u < 64; u += G) {
        const int rb = u & 3, ct = u >> 2, row0 = SEQ + 64 * rb, c0 = 64 * ct;
        f32x16 acc[2][2]; SMM_ZERO(acc);
        kloop<2>(acc, PB + (size_t)(row0 + r32) * DPLE + 8 * hi, DPLE, Wp + (size_t)(c0 + r32) * DPLE + 8 * hi, Wp + (size_t)(c0 + 32 + r32) * DPLE + 8 * hi, 32 * w, 32);
        float pj[8]; reduce8(acc, lds, tid, w, r32, hi, pj);
        SMM_ZERO(acc);
        kloop<4>(acc, HB + (size_t)(row0 + r32) * DM + 8 * hi, DM, Wg + (size_t)(c0 + r32) * DM + 8 * hi, Wg + (size_t)(c0 + 32 + r32) * DM + 8 * hi, 128 * w, 128);
        float v[8]; reduce8(acc, lds, tid, w, r32, hi, v);
        const int row = row0 + (tid >> 3), cg = tid & 7; const float r = pg8::row_rscale(ssq_in, row); const size_t off = (size_t)row * DM + c0 + 8 * cg;
        f32x4 h0, h1; pg8::unpack8(*(const u32x4*)(HB + off), h0, h1);
#pragma unroll
        for (int i = 0; i < 8; ++i) v[i] = (i < 4 ? h0[i] : h1[i - 4]) + __builtin_amdgcn_rcpf(1.0f + __builtin_amdgcn_exp2f(-LOG2E * r * v[i])) * pj[i];
        if (yout) { float* yo = yout + (size_t)(row - SEQ) * DM + c0 + 8 * cg; *(f32x4*)yo = (f32x4){v[0], v[1], v[2], v[3]}; *(f32x4*)(yo + 4) = (f32x4){v[4], v[5], v[6], v[7]}; }
        *(u32x4*)(hb + off) = pack8v(v);
        const float s = xor8(sum8sq(v));
        if (cg == 0) ssq_out[(size_t)row * 16 + ct] = s;
    }
}
template <int ST>
__device__ __forceinline__ void kloop16(f32x4v (&acc)[4], const bf16* A0  , const bf16* B0  , size_t ldb, int k0, int klen) {
    for (int kc = k0; kc < k0 + klen; kc += 32 * ST) {
        bf16x8 af[ST], bf[ST][4];
#pragma unroll
        for (int s = 0; s < ST; ++s) { af[s] = *(const bf16x8*)(A0 + kc + 32 * s);
#pragma unroll
            for (int jn = 0; jn < 4; ++jn) bf[s][jn] = *(const bf16x8*)(B0 + (size_t)(16 * jn) * ldb + kc + 32 * s); }
#pragma unroll
        for (int s = 0; s < ST; ++s)
#pragma unroll
            for (int jn = 0; jn < 4; ++jn) acc[jn] = __builtin_amdgcn_mfma_f32_16x16x32_bf16(af[s], bf[s][jn], acc[jn], 0, 0, 0);
    }
}
__device__ __forceinline__ void reduce16(const f32x4v (&acc)[4], lptr lds, int tid, int w, int lane, float (&v)[8]) {
    ALDS float* part = (ALDS float*)lds + w * 1024;
#pragma unroll
    for (int jn = 0; jn < 4; ++jn)
#pragma unroll
        for (int r = 0; r < 4; ++r) part[(4 * (lane >> 4) + r) * 64 + 16 * jn + (lane & 15)] = acc[jn][r];
    __syncthreads();
    f32x4 s0 = (f32x4){0.f, 0.f, 0.f, 0.f}, s1 = s0;
    if (tid < 128) { const int row = tid >> 3, cg = tid & 7;
#pragma unroll
        for (int ww = 0; ww < 8; ++ww) { const ALDS float* p = (const ALDS float*)lds + ww * 1024 + row * 64 + 8 * cg; s0 += *(const ALDS f32x4*)p; s1 += *(const ALDS f32x4*)(p + 4); } }
    __syncthreads();
#pragma unroll
    for (int i = 0; i < 4; ++i) { v[i] = s0[i]; v[4 + i] = s1[i]; }
}
#define SMM_ZERO16(acc) do { _Pragma("unroll") for (int j_ = 0; j_ < 4; ++j_) acc[j_] = (f32x4v){0.f, 0.f, 0.f, 0.f}; } while (0)
template <int R16_ST>
__device__ __forceinline__ void residual16(const bf16* A, const bf16* W, int kdim, const bf16_t* hb_in, bf16_t* hb_out, float* ssq, lptr lds, int bx, int G, int tid_in) {
    SMM_IDS; (void)r32; (void)hi;
    for (int u = bx; u < 256; u += G) {
        const int row0 = SEQ + 16 * (u & 15), ct = u >> 4, c0 = 64 * ct;
        const int row = row0 + ((tid & 127) >> 3), cg = tid & 7; const size_t off = (size_t)row * DM + c0 + 8 * cg;
        const u32x4 hw = *(const u32x4*)(hb_in + off);
        f32x4v acc[4]; SMM_ZERO16(acc);
        kloop16<R16_ST>(acc, A + (size_t)(row0 + (lane & 15)) * kdim + 8 * (lane >> 4), W + (size_t)(c0 + (lane & 15)) * kdim + 8 * (lane >> 4), (size_t)kdim, (kdim >> 3) * w, kdim >> 3);
        float v[8]; reduce16(acc, lds, tid, w, lane, v);
        if (tid < 128) {
            f32x4 h0, h1; pg8::unpack8(hw, h0, h1);
#pragma unroll
            for (int i = 0; i < 4; ++i) { v[i] += h0[i]; v[4 + i] += h1[i]; }
            *(u32x4*)(hb_out + off) = pack8v(v);
            const float s = xor8(sum8sq(v));
            if (cg == 0) ssq[(size_t)row * 16 + ct] = s;
        }
    }
}
__device__ __forceinline__ void ple16(const bf16* HB, const bf16* Wg, const bf16* PB, const bf16* Wp, const float* ssq_in, bf16_t* hb, float* ssq_out, float* yout  ,
                                      lptr lds, int bx, int G, int tid_in) {
    SMM_IDS; (void)r32; (void)hi;
    for (int u = bx; u < 256; u += G) {
        const int row0 = SEQ + 16 * (u & 15), ct = u >> 4, c0 = 64 * ct;
        const int row = row0 + ((tid & 127) >> 3), cg = tid & 7; const size_t off = (size_t)row * DM + c0 + 8 * cg;
        const float r = pg8::row_rscale(ssq_in, row); const u32x4 hw = *(const u32x4*)(HB + off);
        f32x4v acc[4]; SMM_ZERO16(acc);
        kloop16<1>(acc, PB + (size_t)(row0 + (lane & 15)) * DPLE + 8 * (lane >> 4), Wp + (size_t)(c0 + (lane & 15)) * DPLE + 8 * (lane >> 4), DPLE, 32 * w, 32);
        float pj[8]; reduce16(acc, lds, tid, w, lane, pj);
        SMM_ZERO16(acc);
        kloop16<4>(acc, HB + (size_t)(row0 + (lane & 15)) * DM + 8 * (lane >> 4), Wg + (size_t)(c0 + (lane & 15)) * DM + 8 * (lane >> 4), DM, 128 * w, 128);
        float v[8]; reduce16(acc, lds, tid, w, lane, v);
        if (tid < 128) {
            f32x4 h0, h1; pg8::unpack8(hw, h0, h1);
#pragma unroll
            for (int i = 0; i < 8; ++i) v[i] = (i < 4 ? h0[i] : h1[i - 4]) + __builtin_amdgcn_rcpf(1.0f + __builtin_amdgcn_exp2f(-LOG2E * r * v[i])) * pj[i];
            if (yout) { float* yo = yout + (size_t)(row - SEQ) * DM + c0 + 8 * cg; *(f32x4*)yo = (f32x4){v[0], v[1], v[2], v[3]}; *(f32x4*)(yo + 4) = (f32x4){v[4], v[5], v[6], v[7]}; }
            *(u32x4*)(hb + off) = pack8v(v);
            const float s = xor8(sum8sq(v));
            if (cg == 0) ssq_out[(size_t)row * 16 + ct] = s;
        }
    }
}
__device__ __forceinline__ void expand_kv(int u, const bf16_t* Kb  , float* out, int odd, int j, int tid) {
    const int tz = u >> 8, rb = u & 255; const bf16_t* src = Kb + (size_t)tz * ((size_t)MROWS * DM);
    if (odd) {
        float* dst = out + (tz ? O_PCV : O_PCK) + (size_t)j * SEQ * 1024;
#pragma unroll 4
        for (int it = 0; it < 16; ++it) { const int idx = it * 512 + tid, row = 64 * rb + (idx >> 7), c = (idx & 127) * 8;
            f32x4 a, b_; pg8::unpack8(*(const u32x4*)(src + (size_t)row * DM + c), a, b_);
            float* d = dst + (size_t)row * 1024 + c; __builtin_nontemporal_store(a, (f32x4*)d); __builtin_nontemporal_store(b_, (f32x4*)(d + 4)); }
    } else {
        float* dst = out + (tz ? O_PAV : O_PAK) + (size_t)j * SEQ * 512;
#pragma unroll 4
        for (int it = 0; it < 8; ++it) { const int idx = it * 512 + tid, row = 64 * rb + (idx >> 6), c = (idx & 63) * 8;
            f32x4 a, b_; pg8::unpack8(*(const u32x4*)(src + (size_t)row * DM + c), a, b_);
            float* d = dst + (size_t)row * 512 + c; __builtin_nontemporal_store(a, (f32x4*)d); __builtin_nontemporal_store(b_, (f32x4*)(d + 4)); }
        if (rb >= 248) {
            float* dstb = out + (tz ? O_PBV : O_PBK) + (size_t)j * 512 * 512;
#pragma unroll 4
            for (int it = 0; it < 8; ++it) { const int idx = it * 512 + tid, row = 64 * rb + (idx >> 6), c = (idx & 63) * 8;
                f32x4 a, b_; pg8::unpack8(*(const u32x4*)(src + (size_t)row * DM + 512 + c), a, b_);
                float* d = dstb + (size_t)(row - (SEQ - 512)) * 512 + c; __builtin_nontemporal_store(a, (f32x4*)d); __builtin_nontemporal_store(b_, (f32x4*)(d + 4)); }
        }
    }
}
__device__ __forceinline__ void expand_kv_even_waves(int u, const bf16_t* Kb, float* out, int j, int lane, int vw, int nw) {
    const int tz = u >> 8, rb = u & 255; const bf16_t* src = Kb + (size_t)tz * ((size_t)MROWS * DM);
    float* dst = out + (tz ? O_PAV : O_PAK) + (size_t)j * SEQ * 512; const int c = lane * 8;
#pragma unroll 2
    for (int r = vw; r < 64; r += nw) { const int row = 64 * rb + r;
        f32x4 a, b_; pg8::unpack8(*(const u32x4*)(src + (size_t)row * DM + c), a, b_);
        float* d = dst + (size_t)row * 512 + c; __builtin_nontemporal_store(a, (f32x4*)d); __builtin_nontemporal_store(b_, (f32x4*)(d + 4)); }
    if (rb >= 248) {
        float* dstb = out + (tz ? O_PBV : O_PBK) + (size_t)j * 512 * 512;
#pragma unroll 2
        for (int r = vw; r < 64; r += nw) { const int row = 64 * rb + r;
            f32x4 a, b_; pg8::unpack8(*(const u32x4*)(src + (size_t)row * DM + 512 + c), a, b_);
            float* d = dstb + (size_t)(row - (SEQ - 512)) * 512 + c; __builtin_nontemporal_store(a, (f32x4*)d); __builtin_nontemporal_store(b_, (f32x4*)(d + 4)); }
    }
}
#undef SMM_IDS
#undef SMM_ZERO
}

#include <hip/hip_bf16.h>
namespace fox {
#define FLDS __attribute__((address_space(3)))
using bf16=__hip_bfloat16;
using bf16x8=__attribute__((ext_vector_type(8)))short;
using s16x4=__attribute__((ext_vector_type(4)))short;
using f32x16=__attribute__((ext_vector_type(16)))float;
using u32x4=__attribute__((ext_vector_type(4)))unsigned;
constexpr int BATCH=1,NHEAD=16,SEQ=16384,D=64,DM=NHEAD*D;
constexpr int NW=8,QBLK=32,QB=QBLK*NW,KVBLK=64,NQB=SEQ/QB;
constexpr int ATTN_PITCH=DM, ATTN_UNIT_ROWS=QB;
__device__ __forceinline__ int crow(int r,int hi){return (r&3)+8*(r>>2)+4*hi;}
#define SBAR() __builtin_amdgcn_sched_barrier(0)
__device__ __forceinline__ void cmask(f32x16&p0,f32x16&p1,int jb,int qrel,int hi){
  const float NEG=-INFINITY; int kb=64*jb+4*hi;
  #pragma unroll
  for(int r=0;r<16;++r){int kv=kb+(r&3)+8*(r>>2); if(kv>qrel)p0[r]=NEG; if(kv+32>qrel)p1[r]=NEG;}
}

constexpr int NSLOT=3, SLOTB=8192;
constexpr int LDS_K=0, LDS_V=NSLOT*SLOTB, LDS_WS=2*NSLOT*SLOTB, LDS_OST=LDS_WS+NW*64*4, LDS_BT=LDS_OST,LDS_BYTES=LDS_BT+65536;
constexpr float C2=0.125f*1.4426950408889634f;
__device__ __forceinline__ void glds16(const void*gsrc,unsigned lds_dst){unsigned keep;
  asm volatile("s_mov_b32 %0, m0\n\ts_mov_b32 m0, %2\n\ts_nop 0\n\tglobal_load_lds_dwordx4 %1, off\n\ts_mov_b32 m0, %0":"=&s"(keep):"v"(gsrc),"s"(lds_dst):"memory");}
__device__ __forceinline__ float max3f(float a,float b,float c){float r;asm("v_max3_f32 %0, %1, %2, %3":"=v"(r):"v"(a),"v"(b),"v"(c));return r;}
__device__ __forceinline__ float max2f(float a,float b){float r;asm("v_max_f32_e32 %0, %1, %2":"=v"(r):"v"(a),"v"(b));return r;}
__device__ __forceinline__ float fadd_s(float a,float b){float r;asm("v_add_f32_e32 %0, %1, %2":"=v"(r):"v"(a),"v"(b));return r;}
__device__ __forceinline__ float fsub_s(float a,float b){float r;asm("v_sub_f32_e32 %0, %1, %2":"=v"(r):"v"(a),"v"(b));return r;}
typedef float f32x2_t __attribute__((ext_vector_type(2))); typedef __bf16 bf16x2_t __attribute__((ext_vector_type(2)));
__device__ __forceinline__ unsigned cvtpk_s(float lo,float hi){f32x2_t v={lo,hi};bf16x2_t b=__builtin_convertvector(v,bf16x2_t);return __builtin_bit_cast(unsigned,b);}
#define WAIT_BAR(N) asm volatile("s_waitcnt vmcnt(" #N ") lgkmcnt(0)\n\ts_barrier":::"memory")

typedef short s16x4b __attribute__((ext_vector_type(4)));
#define BIASK(C,AB,BQ) C=__builtin_amdgcn_mfma_f32_32x32x8bf16_1k(AB,BQ,C,0,0,0)
__device__ __forceinline__ void qkt(f32x16&p0,f32x16&p1,const FLDS char*Kslot,const bf16x8*qr,s16x4b ab0,s16x4b ab1,s16x4b bq,int r32,int hi){
  const f32x16 zz=f32x16{};
  const FLDS char*kb=Kslot+hi*1024+r32*16;
  #pragma unroll
  for(int d0=0;d0<4;++d0){
    const bf16x8 b0=*(const FLDS bf16x8*)(kb+d0*2048);
    const bf16x8 b1=*(const FLDS bf16x8*)(kb+d0*2048+512);
    if(d0==0){p0=__builtin_amdgcn_mfma_f32_32x32x16_bf16(b0,qr[0],zz,0,0,0);p1=__builtin_amdgcn_mfma_f32_32x32x16_bf16(b1,qr[0],zz,0,0,0);}
    else{p0=__builtin_amdgcn_mfma_f32_32x32x16_bf16(b0,qr[d0],p0,0,0,0);p1=__builtin_amdgcn_mfma_f32_32x32x16_bf16(b1,qr[d0],p1,0,0,0);}}
  BIASK(p0,ab0,bq);BIASK(p1,ab1,bq);
}
typedef __attribute__((address_space(3))) const char* lds_cptr;
typedef short v4i16_t __attribute__((ext_vector_type(4)));
__device__ __forceinline__ void kload8(bf16x8*kf,lds_cptr kp){
  kf[0]=*(const __attribute__((address_space(3))) bf16x8*)(kp);      kf[1]=*(const __attribute__((address_space(3))) bf16x8*)(kp+512);
  kf[2]=*(const __attribute__((address_space(3))) bf16x8*)(kp+2048); kf[3]=*(const __attribute__((address_space(3))) bf16x8*)(kp+2560);
  kf[4]=*(const __attribute__((address_space(3))) bf16x8*)(kp+4096); kf[5]=*(const __attribute__((address_space(3))) bf16x8*)(kp+4608);
  kf[6]=*(const __attribute__((address_space(3))) bf16x8*)(kp+6144); kf[7]=*(const __attribute__((address_space(3))) bf16x8*)(kp+6656);
}
__device__ __forceinline__ void kload2(bf16x8*kf,lds_cptr kp,int j){ kf[2*j]=*(const __attribute__((address_space(3))) bf16x8*)(kp+j*2048); kf[2*j+1]=*(const __attribute__((address_space(3))) bf16x8*)(kp+j*2048+512); }
__device__ __forceinline__ s16x4 vtr(lds_cptr p){ return __builtin_bit_cast(s16x4,__builtin_amdgcn_ds_read_tr16_b64_v4i16((__attribute__((address_space(3))) v4i16_t*)p)); }
__device__ __forceinline__ float rowmax(const f32x16&p0,const f32x16&p1){
  float a=max3f(p0[0],p0[1],p1[0]),b=max3f(p0[2],p0[3],p1[1]);a=max3f(a,p1[2],p1[3]);
  #pragma unroll
  for(int r=4;r<16;r+=4){a=max3f(a,p0[r],p0[r+1]);b=max3f(b,p0[r+2],p0[r+3]);a=max3f(a,p1[r],p1[r+1]);b=max3f(b,p1[r+2],p1[r+3]);}
  const float m=max2f(a,b);
  auto rr=__builtin_amdgcn_permlane32_swap(__float_as_uint(m),__float_as_uint(m),false,false);
  return max2f(__uint_as_float(rr[0]),__uint_as_float(rr[1]));
}
__device__ __forceinline__ void pv(f32x16*o,int vb,bf16x8 pa0,bf16x8 pa1,bf16x8 pa2,bf16x8 pa3){
  #pragma unroll
  for(int d0=0;d0<2;++d0){s16x4 lo[4],hi[4];
    #pragma unroll
    for(int ks=0;ks<4;++ks){
      asm volatile("ds_read_b64_tr_b16 %0,%1 offset:%c2":"=&v"(lo[ks]):"v"(vb),"i"(d0*4096+ks*1024):"memory");
      asm volatile("ds_read_b64_tr_b16 %0,%1 offset:%c2":"=&v"(hi[ks]):"v"(vb),"i"(d0*4096+ks*1024+512):"memory");}
    asm volatile("s_waitcnt lgkmcnt(0)":::"memory");SBAR();
    #define PK(k) (bf16x8){lo[k][0],lo[k][1],lo[k][2],lo[k][3],hi[k][0],hi[k][1],hi[k][2],hi[k][3]}
    o[d0]=__builtin_amdgcn_mfma_f32_32x32x16_bf16(pa0,PK(0),o[d0],0,0,0);
    o[d0]=__builtin_amdgcn_mfma_f32_32x32x16_bf16(pa1,PK(1),o[d0],0,0,0);
    o[d0]=__builtin_amdgcn_mfma_f32_32x32x16_bf16(pa2,PK(2),o[d0],0,0,0);
    o[d0]=__builtin_amdgcn_mfma_f32_32x32x16_bf16(pa3,PK(3),o[d0],0,0,0);
    #undef PK
  }
}

#ifndef ATTN_STORE16
#define ATTN_STORE16(p,v) (*(u32x4*)(p)=(v))
#endif
template<int THRL> __device__ __forceinline__ void attn_unit(int b,int h,int qb,int t_first,const float*LPh,const FLDS double*dbase,const bf16*Q,const bf16*__restrict__ K,const bf16*__restrict__ V,bf16*O,FLDS char*shm,int tid_in){
  int tid_=tid_in; asm volatile("":"+v"(tid_)); const int tid=tid_,lane=tid&63,r32=lane&31,hi=lane>>5; const int wid=__builtin_amdgcn_readfirstlane(tid>>6);
  const long rowbase=(long)b*SEQ; const int q0=qb*QB;
  const bf16*Qw=Q+(rowbase+q0+wid*QBLK)*DM+h*D;
  const bf16*Kh=K+(rowbase+(long)t_first*KVBLK)*DM+h*D,*Vh=V+(rowbase+(long)t_first*KVBLK)*DM+h*D;
  const unsigned lds0=(unsigned)(uintptr_t)shm;
  FLDS float*wsf=(FLDS float*)(shm+LDS_WS)+wid*64;
  const bf16*ksrc=Kh+(long)lane*DM+wid*8;
  const bf16*vsrc=Vh+(long)(16*(wid&3)+(lane>>2))*DM+(wid>>2)*32+(lane&3)*8;
  const unsigned kdst=lds0+LDS_K+wid*1024, vdst=lds0+LDS_V+wid*1024;
  #define DMA_K(t,slot) glds16(ksrc+(long)(t)*KVBLK*DM,(unsigned)__builtin_amdgcn_readfirstlane(kdst+(slot)))
  #define DMA_V(t,slot) glds16(vsrc+(long)(t)*KVBLK*DM,(unsigned)__builtin_amdgcn_readfirstlane(vdst+(slot)))
  const int vb0=(int)(lds0+LDS_V)+((lane>>4)&1)*32+(lane&3)*8+(4*hi+((lane&15)>>2))*64;
  const FLDS char*Kbase=shm+LDS_K; bf16x8 kf[8];
  const lds_cptr shm3=(lds_cptr)shm; const lds_cptr kp0=shm3+LDS_K+hi*1024+r32*16; const lds_cptr vp0=shm3+LDS_V+((lane>>4)&1)*32+(lane&3)*8+(4*hi+((lane&15)>>2))*64;
  const int NT=(q0+QB)/KVBLK-t_first;
  DMA_K(0,0);DMA_V(0,0);DMA_K(1,SLOTB);
  { const double dref=dbase[(q0+QB-1)>>6]+(double)LPh[q0+QB-1]; FLDS unsigned*bt=(FLDS unsigned*)(shm+LDS_BT);
    const float*Lt=LPh+(long)t_first*KVBLK; const int NE=NT*KVBLK;
    for(int i0=0;i0<NE;i0+=8*NW*64){ double dv[8];
      _Pragma("unroll") for(int k=0;k<8;++k){ const int i=i0+k*NW*64+tid; dv[k]=(i<NE)?dbase[t_first+(i>>6)]+(double)Lt[i]:dref; }
      _Pragma("unroll") for(int k=0;k<8;++k){ const int i=i0+k*NW*64+tid; const float bv=(float)(dref-dv[k])*1.4426950408889634f; const float bh=__uint_as_float(cvtpk_s(bv,0.f)<<16); if(i<NE)bt[i]=cvtpk_s(bh,bv-bh); } } }
  const FLDS unsigned*btl=(const FLDS unsigned*)(shm+LDS_BT)+r32;
  const short AY1=hi?(short)0:(short)0x3F80; const unsigned BQX=hi?0u:0x3F803F80u;
  #define ABK(t,o) __builtin_bit_cast(s16x4b,(unsigned long long)btl[(t)*KVBLK+(o)]|((unsigned long long)(unsigned short)AY1<<48))
  #define BQV() __builtin_bit_cast(s16x4b,(unsigned long long)BQX|((unsigned long long)(hi?0u:(__float_as_uint(-mhat)&0xffff0000u))<<32))

  bf16x8 qr[4];
  #pragma unroll
  for(int d0=0;d0<4;++d0)qr[d0]=*reinterpret_cast<const bf16x8*>(&Qw[(long)r32*DM+d0*16+hi*8]);
  float mhat=0.f,l_reg=0.f;f32x16 o[2];o[0]=f32x16{};o[1]=f32x16{};s16x4b bq=BQV();
  const f32x16 zz=f32x16{};
  const int qrel=wid*QBLK+r32;
  #define CMASK(P0,P1,t) do{int jb_=(t)-(NT-4); if(jb_>=0)cmask(P0,P1,jb_,qrel,hi);}while(0)
  bool resc=false;
  #define START(P0,P1) do{ const float rm=rowmax(P0,P1); resc=false; \
    { const float mn_=__uint_as_float(cvtpk_s(mhat+rm,0.f)<<16); const float dl=mn_-mhat; mhat=mn_; \
      _Pragma("unroll") for(int r=0;r<16;++r){P0[r]=fsub_s(P0[r],dl);P1[r]=fsub_s(P1[r],dl);} \
      bq=BQV(); asm volatile("":"+v"(bq)); } \
    _Pragma("unroll") for(int r=0;r<16;++r)P0[r]=__builtin_amdgcn_exp2f(P0[r]); }while(0)
  #define RESC() do{ if(resc){ asm volatile("s_waitcnt lgkmcnt(0)":::"memory"); \
      _Pragma("unroll") for(int d_=0;d_<2;++d_) _Pragma("unroll") for(int r=0;r<16;++r)o[d_][r]*=wsf[crow(r,hi)]; } }while(0)
  f32x16 pA0,pA1,pB0,pB1;
  int sl_prev=0,sl_cur=0,sl_next=SLOTB;
  #define ROT() do{sl_prev=sl_cur;sl_cur=sl_next;sl_next=(sl_next==(NSLOT-1)*SLOTB)?0:sl_next+SLOTB;}while(0)
  DMA_K(2,2*SLOTB);
  WAIT_BAR(3);
  qkt(pA0,pA1,Kbase,qr,ABK(0,0),ABK(0,32),bq,r32,hi);asm volatile("s_nop 15\n\ts_nop 7":"+v"(pA0),"+v"(pA1));CMASK(pA0,pA1,0);
  START(pA0,pA1);
  _Pragma("unroll") for(int r=0;r<16;++r)pA1[r]=__builtin_amdgcn_exp2f(pA1[r]);
  WAIT_BAR(0);
  DMA_K(3,0);DMA_V(1,SLOTB);
  ROT();
  kload8(kf,kp0+sl_cur);
  WAIT_BAR(2);
  s16x4 vlo[8],vhi[8]; u32x4 pw0,pw1,pw2,pw3;
  #define PKW(P,B) cvtpk_s(P[B],P[B+1])
  #define PAF(k) __builtin_bit_cast(bf16x8,pw##k)
  #define VFR(i) (bf16x8){vlo[i][0],vlo[i][1],vlo[i][2],vlo[i][3],vhi[i][0],vhi[i][1],vhi[i][2],vhi[i][3]}
  #define PIN(x) asm volatile("":"+v"(x))
  #define MX3(a,b,c) __builtin_fmaxf(__builtin_fmaxf((a),(b)),(c))
  #define GAPA(MF,A0,A1,A2,A3,W0,W1,PW) do{ MF; sacc+=A0; sacc+=A1; sacc+=A2; sacc+=A3; PIN(sacc); W0; W1; PIN(PW); SBAR(); }while(0)
  #define EX(v) __builtin_amdgcn_exp2f(v)
  #define GAPB(MF,X,B) do{ MF; X[B]=EX(X[B]); X[B+1]=EX(X[B+1]); X[B+2]=EX(X[B+2]); X[B+3]=EX(X[B+3]); PIN(X); SBAR(); }while(0)
  #define VRD(i) do{ vlo[i]=vtr(vp_+(((i)>>2)*4096+((i)&3)*1024)); vhi[i]=vtr(vp_+(((i)>>2)*4096+((i)&3)*1024+512)); }while(0)
  #define KRD(G,j) do{ if(G){ kload2(kf,kp0+sl_next,j); SBAR(); } }while(0)
  #define STEP(C0,C1,P0,P1,t,GK,GV,GL) do{ SBAR(); \
    const s16x4b ab0_=ABK(t,0),ab1_=ABK(t,32); \
    const lds_cptr vp_=vp0+sl_prev; \
    VRD(0); SBAR(); float sacc=(P0[0]+P0[1]); \
    GAPA(C0=__builtin_amdgcn_mfma_f32_32x32x16_bf16(kf[0],qr[0],zz,0,0,0), P0[2],P0[3],P0[4],P0[5],     pw0[0]=PKW(P0,0), pw0[1]=PKW(P0,2), pw0); \
    VRD(4); SBAR(); GAPA(C1=__builtin_amdgcn_mfma_f32_32x32x16_bf16(kf[1],qr[0],zz,0,0,0), P0[6],P0[7],P0[8],P0[9],     pw0[2]=PKW(P0,4), pw0[3]=PKW(P0,6), pw0); \
    VRD(1); SBAR(); GAPA(C0=__builtin_amdgcn_mfma_f32_32x32x16_bf16(kf[2],qr[1],C0,0,0,0),   P0[10],P0[11],P0[12],P0[13], pw1[0]=PKW(P0,8), pw1[1]=PKW(P0,10), pw1); \
    VRD(5); SBAR(); GAPA(C1=__builtin_amdgcn_mfma_f32_32x32x16_bf16(kf[3],qr[1],C1,0,0,0),   P0[14],P0[15],P1[0],P1[1],   pw1[2]=PKW(P0,12),pw1[3]=PKW(P0,14), pw1); \
    VRD(2); SBAR(); GAPA(C0=__builtin_amdgcn_mfma_f32_32x32x16_bf16(kf[4],qr[2],C0,0,0,0),   P1[2],P1[3],P1[4],P1[5],     pw2[0]=PKW(P1,0), pw2[1]=PKW(P1,2), pw2); \
    VRD(6); SBAR(); GAPA(C1=__builtin_amdgcn_mfma_f32_32x32x16_bf16(kf[5],qr[2],C1,0,0,0),   P1[6],P1[7],P1[8],P1[9],     pw2[2]=PKW(P1,4), pw2[3]=PKW(P1,6), pw2); \
    VRD(3); SBAR(); GAPA(C0=__builtin_amdgcn_mfma_f32_32x32x16_bf16(kf[6],qr[3],C0,0,0,0),   P1[10],P1[11],P1[12],P1[13], pw3[0]=PKW(P1,8), pw3[1]=PKW(P1,10), pw3); \
    VRD(7); SBAR(); GAPA(C1=__builtin_amdgcn_mfma_f32_32x32x16_bf16(kf[7],qr[3],C1,0,0,0),   P1[14],P1[15],0.f,0.f,       pw3[2]=PKW(P1,12),pw3[3]=PKW(P1,14), pw3); \
    BIASK(C0,ab0_,bq); BIASK(C1,ab1_,bq); \
    l_reg+=sacc; \
    if(GK){DMA_K((t)+3,sl_cur);} if(GV){DMA_V((t)+1,sl_next);} \
    CMASK(C0,C1,t); \
    { float a=MX3(C0[0],C0[1],C1[0]),b=MX3(C0[2],C0[3],C1[1]); a=MX3(a,C1[2],C1[3]); \
      _Pragma("unroll") for(int r=4;r<16;r+=4){a=MX3(a,C0[r],C0[r+1]);b=MX3(b,C0[r+2],C0[r+3]);a=MX3(a,C1[r],C1[r+1]);b=MX3(b,C1[r+2],C1[r+3]);} \
      float rm=__builtin_fmaxf(a,b); { auto rr=__builtin_amdgcn_permlane32_swap(__float_as_uint(rm),__float_as_uint(rm),false,false); rm=__builtin_fmaxf(__uint_as_float(rr[0]),__uint_as_float(rr[1])); } \
      resc=false; \
      if(__builtin_expect(__any(rm>(float)THRL),0)){ const float mn_=__uint_as_float(cvtpk_s(mhat+__builtin_fmaxf(rm,0.f),0.f)<<16); const float dl=mn_-mhat; mhat=mn_; \
        _Pragma("unroll") for(int r=0;r<16;++r){C0[r]-=dl;C1[r]-=dl;} \
        bq=BQV(); asm volatile("":"+v"(bq)); \
        const float f=__builtin_amdgcn_exp2f(-dl); l_reg*=f; if(hi==0)wsf[r32]=f; resc=true; } } \
    SBAR(); \
    GAPB(o[0]=__builtin_amdgcn_mfma_f32_32x32x16_bf16(PAF(0),VFR(0),o[0],0,0,0), C0,0); \
    GAPB(o[1]=__builtin_amdgcn_mfma_f32_32x32x16_bf16(PAF(0),VFR(4),o[1],0,0,0), C0,4); \
    KRD(GL,0); GAPB(o[0]=__builtin_amdgcn_mfma_f32_32x32x16_bf16(PAF(1),VFR(1),o[0],0,0,0), C0,8); \
    KRD(GL,1); GAPB(o[1]=__builtin_amdgcn_mfma_f32_32x32x16_bf16(PAF(1),VFR(5),o[1],0,0,0), C0,12); \
    KRD(GL,2); GAPB(o[0]=__builtin_amdgcn_mfma_f32_32x32x16_bf16(PAF(2),VFR(2),o[0],0,0,0), C1,0); \
    KRD(GL,3); GAPB(o[1]=__builtin_amdgcn_mfma_f32_32x32x16_bf16(PAF(2),VFR(6),o[1],0,0,0), C1,4); \
    GAPB(o[0]=__builtin_amdgcn_mfma_f32_32x32x16_bf16(PAF(3),VFR(3),o[0],0,0,0), C1,8); \
    GAPB(o[1]=__builtin_amdgcn_mfma_f32_32x32x16_bf16(PAF(3),VFR(7),o[1],0,0,0), C1,12); \
    }while(0)
  int t=1;
  #undef CMASK
  #define CMASK(P0,P1,t) do{}while(0)
  for(;t+5<NT;t+=2){
    STEP(pB0,pB1,pA0,pA1,t,true,true,true);     WAIT_BAR(2); RESC(); ROT();
    STEP(pA0,pA1,pB0,pB1,t+1,true,true,true);   WAIT_BAR(2); RESC(); ROT();
  }
  #undef CMASK
  #define CMASK(P0,P1,t) do{int jb_=(t)-(NT-4); if(jb_>=0)cmask(P0,P1,jb_,qrel,hi);}while(0)
  #define ENDW(tt) do{ if((tt)+3<NT){WAIT_BAR(2);} else if((tt)+2<NT){WAIT_BAR(1);} else {WAIT_BAR(0);} }while(0)
  for(;t+1<NT;t+=2){
    STEP(pB0,pB1,pA0,pA1,t,(t+3<NT),(t+1<NT),(t+1<NT));       ENDW(t);   RESC(); ROT();
    STEP(pA0,pA1,pB0,pB1,t+1,(t+4<NT),(t+2<NT),(t+2<NT));     ENDW(t+1); RESC(); ROT();
  }
  STEP(pB0,pB1,pA0,pA1,NT-1,false,false,false); RESC();
  { float sacc=pB0[0]+pB0[1]; _Pragma("unroll") for(int r=2;r<16;++r)sacc+=pB0[r]; _Pragma("unroll") for(int r=0;r<16;++r)sacc+=pB1[r]; l_reg+=sacc;
    pw0=(u32x4){PKW(pB0,0),PKW(pB0,2),PKW(pB0,4),PKW(pB0,6)};pw1=(u32x4){PKW(pB0,8),PKW(pB0,10),PKW(pB0,12),PKW(pB0,14)};pw2=(u32x4){PKW(pB1,0),PKW(pB1,2),PKW(pB1,4),PKW(pB1,6)};pw3=(u32x4){PKW(pB1,8),PKW(pB1,10),PKW(pB1,12),PKW(pB1,14)};
    SBAR(); pv(o,vb0+sl_cur,PAF(0),PAF(1),PAF(2),PAF(3)); }
  #undef PKW
  #undef PAF
  #undef VFR
  #undef PIN
  #undef MX3
  #undef GAPA
  #undef GAPB
  #undef EX
  #undef VRD
  #undef KRD
  #undef STEP
  #undef ENDW
  {auto rr=__builtin_amdgcn_permlane32_swap(__float_as_uint(l_reg),__float_as_uint(l_reg),false,false);l_reg=__uint_as_float(rr[0])+__uint_as_float(rr[1]);}
  if(hi==0)wsf[32+r32]=l_reg;asm volatile("s_waitcnt lgkmcnt(0)":::"memory");
  float rli[16];
  #pragma unroll
  for(int r=0;r<16;++r)rli[r]=__builtin_amdgcn_rcpf(wsf[32+crow(r,hi)]);
  bf16*Ow=O+(rowbase+q0+wid*QBLK)*DM+h*D;
  asm volatile("s_waitcnt lgkmcnt(0)\n\ts_barrier":::"memory");
  { FLDS unsigned short*stg=(FLDS unsigned short*)(shm+LDS_OST)+wid*2048;
    #pragma unroll
    for(int r=0;r<16;++r){const int orow=crow(r,hi);
      #pragma unroll
      for(int d0=0;d0<2;++d0)stg[orow*64+d0*32+r32]=(unsigned short)(cvtpk_s(o[d0][r]*rli[r],0.f)&0xffffu);}
    asm volatile("s_waitcnt lgkmcnt(0)":::"memory");
    #pragma unroll
    for(int i=0;i<4;++i){const int row=i*8+(lane>>3),ch=lane&7; const u32x4 v=*(const FLDS u32x4*)(stg+row*64+ch*8); ATTN_STORE16(Ow+(long)row*DM+ch*8,v);} }
  asm volatile("s_waitcnt lgkmcnt(0)\n\ts_barrier":::"memory");
  #undef DMA_K
  #undef DMA_V
  #undef CMASK
  #undef ABK
  #undef BQV
  #undef START
  #undef RESC
  #undef ROT
}
template<int THRL> __device__ __forceinline__ void band_unit(int h,int qb,const float*relg,const bf16*Q,const bf16*__restrict__ K,const bf16*__restrict__ V,bf16*O,FLDS char*shm,int tid_in){
  int tid_=tid_in; asm volatile("":"+v"(tid_)); const int tid=tid_,lane=tid&63,r32=lane&31,hi=lane>>5; const int wid=__builtin_amdgcn_readfirstlane(tid>>6);
  const long rowbase=0; const int q0=qb*QB; const int t0b=(4*qb-8>0)?4*qb-8:0;
  const bf16*Qw=Q+(rowbase+q0+wid*QBLK)*DM+h*D;
  const bf16*Kh=K+(rowbase+(long)t0b*KVBLK)*DM+h*D,*Vh=V+(rowbase+(long)t0b*KVBLK)*DM+h*D;
  const unsigned lds0=(unsigned)(uintptr_t)shm;
  FLDS float*wsf=(FLDS float*)(shm+LDS_WS)+wid*64;
  const bf16*ksrc=Kh+(long)lane*DM+wid*8;
  const bf16*vsrc=Vh+(long)(16*(wid&3)+(lane>>2))*DM+(wid>>2)*32+(lane&3)*8;
  const unsigned kdst=lds0+LDS_K+wid*1024, vdst=lds0+LDS_V+wid*1024;
  #define DMA_K(t,slot) glds16(ksrc+(long)(t)*KVBLK*DM,(unsigned)__builtin_amdgcn_readfirstlane(kdst+(slot)))
  #define DMA_V(t,slot) glds16(vsrc+(long)(t)*KVBLK*DM,(unsigned)__builtin_amdgcn_readfirstlane(vdst+(slot)))
  const int vb0=(int)(lds0+LDS_V)+((lane>>4)&1)*32+(lane&3)*8+(4*hi+((lane&15)>>2))*64;
  const FLDS char*Kbase=shm+LDS_K; bf16x8 kf[8];
  const lds_cptr shm3=(lds_cptr)shm; const lds_cptr kp0=shm3+LDS_K+hi*1024+r32*16; const lds_cptr vp0=shm3+LDS_V+((lane>>4)&1)*32+(lane&3)*8+(4*hi+((lane&15)>>2))*64;
  const int NT=(q0+QB)/KVBLK-t0b;
  DMA_K(0,0);DMA_V(0,0);DMA_K(1,SLOTB);
  { FLDS float*tw=(FLDS float*)(shm+LDS_BT); for(int i=tid;i<257;i+=NW*64)tw[i]=relg[i]*1.4426950408889634f; }
  const FLDS float*tab=(const FLDS float*)(shm+LDS_BT);
  const int cqr=(NT-4)+(wid>>1);
  const float tbf=relg[256]*1.4426950408889634f; const float tbfh=__uint_as_float(cvtpk_s(tbf,0.f)<<16); const unsigned TBFAR=cvtpk_s(tbfh,tbf-tbfh), TBMASK=cvtpk_s(-29952.f,-48.f);
  const s16x4b ABC=__builtin_bit_cast(s16x4b,hi?0ull:(0x3F803F80ull|(0x3F80ull<<48)));
  #define TBX(t) ((cqr-(t)<0||cqr-(t)>8)?TBMASK:((cqr-(t)>=3)?TBFAR:0u))
  #define BQV(t) __builtin_bit_cast(s16x4b,(unsigned long long)TBX(t)|((unsigned long long)(__float_as_uint(-mhat)&0xffff0000u)<<32))
  #define ABK(t,o) ABC

  bf16x8 qr[4];
  #pragma unroll
  for(int d0=0;d0<4;++d0)qr[d0]=*reinterpret_cast<const bf16x8*>(&Qw[(long)r32*DM+d0*16+hi*8]);
  float mhat=0.f,l_reg=0.f;f32x16 o[2];o[0]=f32x16{};o[1]=f32x16{};s16x4b bq=BQV(0);
  const f32x16 zz=f32x16{};
  const int qrel=wid*QBLK+r32;
  #define CMASK(P0,P1,t) do{ const int dc_=cqr-(t); if(dc_>=0&&dc_<=2){ const int dq_=64*dc_+32*(wid&1)+r32; _Pragma("unroll") for(int r=0;r<16;++r){ const int d_=dq_-crow(r,hi); const int i0_=d_>128?128:d_, i1_=(d_-32<-128)?-128:((d_-32>128)?128:d_-32); P0[r]+=tab[i0_+128]; P1[r]+=tab[i1_+128]; } } }while(0)
  bool resc=false;
  #define START(P0,P1) do{ const float rm=rowmax(P0,P1); resc=false; \
    { const float mn_=__uint_as_float(cvtpk_s(mhat+rm,0.f)<<16); const float dl=mn_-mhat; mhat=mn_; \
      _Pragma("unroll") for(int r=0;r<16;++r){P0[r]=fsub_s(P0[r],dl);P1[r]=fsub_s(P1[r],dl);} \
      bq=BQV(0); asm volatile("":"+v"(bq)); } \
    _Pragma("unroll") for(int r=0;r<16;++r)P0[r]=__builtin_amdgcn_exp2f(P0[r]); }while(0)
  #define RESC() do{ if(resc){ asm volatile("s_waitcnt lgkmcnt(0)":::"memory"); \
      _Pragma("unroll") for(int d_=0;d_<2;++d_) _Pragma("unroll") for(int r=0;r<16;++r)o[d_][r]*=wsf[crow(r,hi)]; } }while(0)
  f32x16 pA0,pA1,pB0,pB1;
  int sl_prev=0,sl_cur=0,sl_next=SLOTB;
  #define ROT() do{sl_prev=sl_cur;sl_cur=sl_next;sl_next=(sl_next==(NSLOT-1)*SLOTB)?0:sl_next+SLOTB;}while(0)
  DMA_K(2,2*SLOTB);
  WAIT_BAR(3);
  qkt(pA0,pA1,Kbase,qr,ABK(0,0),ABK(0,32),bq,r32,hi);asm volatile("s_nop 15\n\ts_nop 7":"+v"(pA0),"+v"(pA1));CMASK(pA0,pA1,0);
  START(pA0,pA1);
  _Pragma("unroll") for(int r=0;r<16;++r)pA1[r]=__builtin_amdgcn_exp2f(pA1[r]);
  WAIT_BAR(0);
  DMA_K(3,0);DMA_V(1,SLOTB);
  ROT();
  kload8(kf,kp0+sl_cur);
  WAIT_BAR(2);
  s16x4 vlo[8],vhi[8]; u32x4 pw0,pw1,pw2,pw3;
  #define PKW(P,B) cvtpk_s(P[B],P[B+1])
  #define PAF(k) __builtin_bit_cast(bf16x8,pw##k)
  #define VFR(i) (bf16x8){vlo[i][0],vlo[i][1],vlo[i][2],vlo[i][3],vhi[i][0],vhi[i][1],vhi[i][2],vhi[i][3]}
  #define PIN(x) asm volatile("":"+v"(x))
  #define MX3(a,b,c) __builtin_fmaxf(__builtin_fmaxf((a),(b)),(c))
  #define GAPA(MF,A0,A1,A2,A3,W0,W1,PW) do{ MF; sacc+=A0; sacc+=A1; sacc+=A2; sacc+=A3; PIN(sacc); W0; W1; PIN(PW); SBAR(); }while(0)
  #define EX(v) __builtin_amdgcn_exp2f(v)
  #define GAPB(MF,X,B) do{ MF; X[B]=EX(X[B]); X[B+1]=EX(X[B+1]); X[B+2]=EX(X[B+2]); X[B+3]=EX(X[B+3]); PIN(X); SBAR(); }while(0)
  #define VRD(i) do{ vlo[i]=vtr(vp_+(((i)>>2)*4096+((i)&3)*1024)); vhi[i]=vtr(vp_+(((i)>>2)*4096+((i)&3)*1024+512)); }while(0)
  #define KRD(G,j) do{ if(G){ kload2(kf,kp0+sl_next,j); SBAR(); } }while(0)
  #define STEP(C0,C1,P0,P1,t,GK,GV,GL) do{ SBAR(); \
    const s16x4b ab0_=ABC,ab1_=ABC; bq=BQV(t); \
    const lds_cptr vp_=vp0+sl_prev; \
    VRD(0); SBAR(); float sacc=(P0[0]+P0[1]); \
    GAPA(C0=__builtin_amdgcn_mfma_f32_32x32x16_bf16(kf[0],qr[0],zz,0,0,0), P0[2],P0[3],P0[4],P0[5],     pw0[0]=PKW(P0,0), pw0[1]=PKW(P0,2), pw0); \
    VRD(4); SBAR(); GAPA(C1=__builtin_amdgcn_mfma_f32_32x32x16_bf16(kf[1],qr[0],zz,0,0,0), P0[6],P0[7],P0[8],P0[9],     pw0[2]=PKW(P0,4), pw0[3]=PKW(P0,6), pw0); \
    VRD(1); SBAR(); GAPA(C0=__builtin_amdgcn_mfma_f32_32x32x16_bf16(kf[2],qr[1],C0,0,0,0),   P0[10],P0[11],P0[12],P0[13], pw1[0]=PKW(P0,8), pw1[1]=PKW(P0,10), pw1); \
    VRD(5); SBAR(); GAPA(C1=__builtin_amdgcn_mfma_f32_32x32x16_bf16(kf[3],qr[1],C1,0,0,0),   P0[14],P0[15],P1[0],P1[1],   pw1[2]=PKW(P0,12),pw1[3]=PKW(P0,14), pw1); \
    VRD(2); SBAR(); GAPA(C0=__builtin_amdgcn_mfma_f32_32x32x16_bf16(kf[4],qr[2],C0,0,0,0),   P1[2],P1[3],P1[4],P1[5],     pw2[0]=PKW(P1,0), pw2[1]=PKW(P1,2), pw2); \
    VRD(6); SBAR(); GAPA(C1=__builtin_amdgcn_mfma_f32_32x32x16_bf16(kf[5],qr[2],C1,0,0,0),   P1[6],P1[7],P1[8],P1[9],     pw2[2]=PKW(P1,4), pw2[3]=PKW(P1,6), pw2); \
    VRD(3); SBAR(); GAPA(C0=__builtin_amdgcn_mfma_f32_32x32x16_bf16(kf[6],qr[3],C0,0,0,0),   P1[10],P1[11],P1[12],P1[13], pw3[0]=PKW(P1,8), pw3[1]=PKW(P1,10), pw3); \
    VRD(7); SBAR(); GAPA(C1=__builtin_amdgcn_mfma_f32_32x32x16_bf16(kf[7],qr[3],C1,0,0,0),   P1[14],P1[15],0.f,0.f,       pw3[2]=PKW(P1,12),pw3[3]=PKW(P1,14), pw3); \
    BIASK(C0,ab0_,bq); BIASK(C1,ab1_,bq); \
    l_reg+=sacc; \
    if(GK){DMA_K((t)+3,sl_cur);} if(GV){DMA_V((t)+1,sl_next);} \
    CMASK(C0,C1,t); \
    { float a=MX3(C0[0],C0[1],C1[0]),b=MX3(C0[2],C0[3],C1[1]); a=MX3(a,C1[2],C1[3]); \
      _Pragma("unroll") for(int r=4;r<16;r+=4){a=MX3(a,C0[r],C0[r+1]);b=MX3(b,C0[r+2],C0[r+3]);a=MX3(a,C1[r],C1[r+1]);b=MX3(b,C1[r+2],C1[r+3]);} \
      float rm=__builtin_fmaxf(a,b); { auto rr=__builtin_amdgcn_permlane32_swap(__float_as_uint(rm),__float_as_uint(rm),false,false); rm=__builtin_fmaxf(__uint_as_float(rr[0]),__uint_as_float(rr[1])); } \
      resc=false; \
      if(__builtin_expect(__any(rm>(float)THRL),0)){ const float mn_=__uint_as_float(cvtpk_s(mhat+__builtin_fmaxf(rm,0.f),0.f)<<16); const float dl=mn_-mhat; mhat=mn_; \
        _Pragma("unroll") for(int r=0;r<16;++r){C0[r]-=dl;C1[r]-=dl;} \
        bq=BQV(t); asm volatile("":"+v"(bq)); \
        const float f=__builtin_amdgcn_exp2f(-dl); l_reg*=f; if(hi==0)wsf[r32]=f; resc=true; } } \
    SBAR(); \
    GAPB(o[0]=__builtin_amdgcn_mfma_f32_32x32x16_bf16(PAF(0),VFR(0),o[0],0,0,0), C0,0); \
    GAPB(o[1]=__builtin_amdgcn_mfma_f32_32x32x16_bf16(PAF(0),VFR(4),o[1],0,0,0), C0,4); \
    KRD(GL,0); GAPB(o[0]=__builtin_amdgcn_mfma_f32_32x32x16_bf16(PAF(1),VFR(1),o[0],0,0,0), C0,8); \
    KRD(GL,1); GAPB(o[1]=__builtin_amdgcn_mfma_f32_32x32x16_bf16(PAF(1),VFR(5),o[1],0,0,0), C0,12); \
    KRD(GL,2); GAPB(o[0]=__builtin_amdgcn_mfma_f32_32x32x16_bf16(PAF(2),VFR(2),o[0],0,0,0), C1,0); \
    KRD(GL,3); GAPB(o[1]=__builtin_amdgcn_mfma_f32_32x32x16_bf16(PAF(2),VFR(6),o[1],0,0,0), C1,4); \
    GAPB(o[0]=__builtin_amdgcn_mfma_f32_32x32x16_bf16(PAF(3),VFR(3),o[0],0,0,0), C1,8); \
    GAPB(o[1]=__builtin_amdgcn_mfma_f32_32x32x16_bf16(PAF(3),VFR(7),o[1],0,0,0), C1,12); \
    }while(0)
  int t=1;
  #undef CMASK
  #define CMASK(P0,P1,t) do{}while(0)
  for(;t+7<NT;t+=2){
    STEP(pB0,pB1,pA0,pA1,t,true,true,true);     WAIT_BAR(2); RESC(); ROT();
    STEP(pA0,pA1,pB0,pB1,t+1,true,true,true);   WAIT_BAR(2); RESC(); ROT();
  }
  #undef CMASK
  #define CMASK(P0,P1,t) do{ const int dc_=cqr-(t); if(dc_>=0&&dc_<=2){ const int dq_=64*dc_+32*(wid&1)+r32; _Pragma("unroll") for(int r=0;r<16;++r){ const int d_=dq_-crow(r,hi); const int i0_=d_>128?128:d_, i1_=(d_-32<-128)?-128:((d_-32>128)?128:d_-32); P0[r]+=tab[i0_+128]; P1[r]+=tab[i1_+128]; } } }while(0)
  #define ENDW(tt) do{ if((tt)+3<NT){WAIT_BAR(2);} else if((tt)+2<NT){WAIT_BAR(1);} else {WAIT_BAR(0);} }while(0)
  for(;t+1<NT;t+=2){
    STEP(pB0,pB1,pA0,pA1,t,(t+3<NT),(t+1<NT),(t+1<NT));       ENDW(t);   RESC(); ROT();
    STEP(pA0,pA1,pB0,pB1,t+1,(t+4<NT),(t+2<NT),(t+2<NT));     ENDW(t+1); RESC(); ROT();
  }
  STEP(pB0,pB1,pA0,pA1,NT-1,false,false,false); RESC();
  { float sacc=pB0[0]+pB0[1]; _Pragma("unroll") for(int r=2;r<16;++r)sacc+=pB0[r]; _Pragma("unroll") for(int r=0;r<16;++r)sacc+=pB1[r]; l_reg+=sacc;
    pw0=(u32x4){PKW(pB0,0),PKW(pB0,2),PKW(pB0,4),PKW(pB0,6)};pw1=(u32x4){PKW(pB0,8),PKW(pB0,10),PKW(pB0,12),PKW(pB0,14)};pw2=(u32x4){PKW(pB1,0),PKW(pB1,2),PKW(pB1,4),PKW(pB1,6)};pw3=(u32x4){PKW(pB1,8),PKW(pB1,10),PKW(pB1,12),PKW(pB1,14)};
    SBAR(); pv(o,vb0+sl_cur,PAF(0),PAF(1),PAF(2),PAF(3)); }
  #undef PKW
  #undef PAF
  #undef VFR
  #undef PIN
  #undef MX3
  #undef GAPA
  #undef GAPB
  #undef EX
  #undef VRD
  #undef KRD
  #undef STEP
  #undef ENDW
  {auto rr=__builtin_amdgcn_permlane32_swap(__float_as_uint(l_reg),__float_as_uint(l_reg),false,false);l_reg=__uint_as_float(rr[0])+__uint_as_float(rr[1]);}
  if(hi==0)wsf[32+r32]=l_reg;asm volatile("s_waitcnt lgkmcnt(0)":::"memory");
  float rli[16];
  #pragma unroll
  for(int r=0;r<16;++r)rli[r]=__builtin_amdgcn_rcpf(wsf[32+crow(r,hi)]);
  bf16*Ow=O+(rowbase+q0+wid*QBLK)*DM+h*D;
  asm volatile("s_waitcnt lgkmcnt(0)\n\ts_barrier":::"memory");
  { FLDS unsigned short*stg=(FLDS unsigned short*)(shm+LDS_OST)+wid*2048;
    #pragma unroll
    for(int r=0;r<16;++r){const int orow=crow(r,hi);
      #pragma unroll
      for(int d0=0;d0<2;++d0)stg[orow*64+d0*32+r32]=(unsigned short)(cvtpk_s(o[d0][r]*rli[r],0.f)&0xffffu);}
    asm volatile("s_waitcnt lgkmcnt(0)":::"memory");
    #pragma unroll
    for(int i=0;i<4;++i){const int row=i*8+(lane>>3),ch=lane&7; const u32x4 v=*(const FLDS u32x4*)(stg+row*64+ch*8); ATTN_STORE16(Ow+(long)row*DM+ch*8,v);} }
  asm volatile("s_waitcnt lgkmcnt(0)\n\ts_barrier":::"memory");
  #undef DMA_K
  #undef DMA_V
  #undef CMASK
  #undef ABK
  #undef BQV
  #undef TBX
  #undef START
  #undef RESC
  #undef ROT
}
constexpr int ATTN_LDS_BYTES=LDS_BYTES;
#undef SBAR
#undef WAIT_BAR
#undef BIASK
#undef FLDS
}

#ifndef N_LAUNCH_PER_PHASE
#define N_LAUNCH_PER_PHASE 0
#endif
constexpr int NWAVES = 8;
constexpr size_t MiB = 1u << 20;
constexpr size_t WS_CTL = 0, CTL_ZERO_BYTES = 1 * MiB;
constexpr size_t WS_WIN = 2 * MiB;
constexpr size_t WIN_STRIDE = (size_t)3328 * 1024 * 2;
constexpr size_t WS_WOUT = WS_WIN + 4 * WIN_STRIDE;
constexpr size_t WS_WFF1 = WS_WOUT + 4 * (size_t)1024 * 1024 * 2;
constexpr size_t WS_WFF2 = WS_WFF1 + 4 * (size_t)4096 * 1024 * 2;
constexpr size_t WS_WG = WS_WFF2 + 4 * (size_t)4096 * 1024 * 2;
constexpr size_t WS_WPP = WS_WG + 4 * (size_t)1024 * 1024 * 2;
constexpr size_t WS_PB = WS_WPP + 4 * (size_t)1024 * 256 * 2;
constexpr size_t WS_HB0 = WS_PB + 4 * (size_t)MROWS * 256 * 2;
constexpr size_t WS_HB1 = WS_HB0 + (size_t)MROWS * DM * 2;
constexpr size_t WS_SSQ0 = WS_HB1 + (size_t)MROWS * DM * 2;
constexpr size_t WS_SSQ1 = WS_SSQ0 + (size_t)MROWS * 16 * 4;
constexpr size_t WS_PP = WS_SSQ1 + (size_t)MROWS * 16 * 4;
constexpr size_t WS_DP = WS_PP + (size_t)MROWS * DM * 2;
constexpr size_t WS_DS = WS_DP + (size_t)16 * SEQ * 8;
constexpr size_t WS_TT = WS_DS + (size_t)256 * (PAST + 16) * 8;
constexpr size_t WS_Q = ((WS_TT + 16 * 256 * 8 + MiB - 1) / MiB) * MiB;
constexpr size_t WS_K = WS_Q + (size_t)MROWS * DM * 2;
constexpr size_t WS_V = WS_K + (size_t)MROWS * DM * 2;
constexpr size_t WS_O = WS_V + (size_t)MROWS * DM * 2;
constexpr size_t WS_HID = WS_Q;
constexpr size_t WS_END = WS_HID + (size_t)MROWS * FF * 2;
constexpr size_t WS_DUMMY = 800 * MiB;
static_assert(WS_END < 768 * MiB && WS_K - WS_Q == (size_t)MROWS * DM * 2 && WS_V - WS_K == (size_t)MROWS * DM * 2, "workspace map");
constexpr int CW_BAR = 4096, CW_QUEUE = 16384;

constexpr int RING_OFF = 0, RING_BYTES = 131072;
constexpr int BTAB_OFF = att::ATT_LDS_BYTES, BTAB_STRIDE = 1040;
constexpr int MISC_OFF = 146944;
constexpr int LDS_BYTES = 147456;
static_assert(BTAB_OFF + 8 * BTAB_STRIDE <= MISC_OFF && att::ATT_LDS_BYTES <= MISC_OFF && fox::ATTN_LDS_BYTES <= MISC_OFF && RING_BYTES <= MISC_OFF && MISC_OFF + 128 <= LDS_BYTES, "LDS map");

#define GAS __attribute__((address_space(1)))
#define LAS __attribute__((address_space(3)))
typedef unsigned short bf16;
typedef unsigned v4u __attribute__((ext_vector_type(4)));
typedef float f32x4 __attribute__((ext_vector_type(4)));
#define LDS_WAIT() asm volatile("s_waitcnt lgkmcnt(0)" ::: "memory")
__device__ __forceinline__ unsigned f2bf(float f) { unsigned u = __builtin_bit_cast(unsigned, f); return (u + 0x7fffu + ((u >> 16) & 1u)) >> 16; }
__device__ __forceinline__ unsigned pk2(float lo, float hi) { return f2bf(lo) | (f2bf(hi) << 16); }
#define XB_TMO      128
#define XB_XCNT(j)  (256  + 64 * (j))
#define XB_XSUB(j)  (1280 + 64 * (j))
#define XB_XGEN(j)  (2304 + 64 * (j))
#define XB_TOP      3328
#define XB_TOPGEN   3392
#define XCD_BAR_WORDS 3456
#define XB_SPIN_CAP (1u << 18)

__device__ __forceinline__ unsigned xb_ld(unsigned* p)              { return __hip_atomic_load(p, __ATOMIC_RELAXED, __HIP_MEMORY_SCOPE_AGENT); }
__device__ __forceinline__ unsigned xb_add(unsigned* p, unsigned v) { return __hip_atomic_fetch_add(p, v, __ATOMIC_RELAXED, __HIP_MEMORY_SCOPE_AGENT); }
__device__ __forceinline__ unsigned xb_xcc_id() { return (unsigned)__builtin_amdgcn_s_getreg((3 << 11) | 20) & 0xFu; }
#define XB_SPIN(cond, bar) do { unsigned _sp = 0; while (cond) { __builtin_amdgcn_s_sleep(1); \
    if ((++_sp & 255u) == 0u) { if (xb_ld(&(bar)[XB_TMO])) break; if (_sp > XB_SPIN_CAP) { atomicAdd(&(bar)[XB_TMO], 1u); break; } } } } while (0)

struct XcdBarrier {
    unsigned* bar; unsigned x;
    volatile LAS unsigned* st;
};

__device__ __forceinline__ XcdBarrier xcd_barrier_post(unsigned* bar, volatile LAS unsigned* st) {
    XcdBarrier b; b.bar = bar; b.x = xb_xcc_id(); b.st = st;
    if (threadIdx.x == 0) (void)xb_add(&bar[XB_XCNT(b.x)], 1u);
    return b;
}
__device__ __forceinline__ void xcd_barrier_complete(unsigned* bar, unsigned x, unsigned& nloc, unsigned& nx) {
    const unsigned G = gridDim.x * gridDim.y * gridDim.z;
    unsigned sum, cnt, mine, sp = 0u;
    for (;;) {
        sum = 0u; cnt = 0u; mine = 0u;
#pragma unroll
        for (unsigned j = 0; j < 16; ++j) { const unsigned c = xb_ld(&bar[XB_XCNT(j)]); sum += c; cnt += (c > 0u) ? 1u : 0u; mine = (j == x) ? c : mine; }
        if (sum == G) break;
        __builtin_amdgcn_s_sleep(1);
        if ((++sp & 255u) == 0u) { if (xb_ld(&bar[XB_TMO])) break; if (sp > XB_SPIN_CAP) { atomicAdd(&bar[XB_TMO], 1u); break; } }
    }
    nloc = mine > 0u ? mine : 1u; nx = cnt > 0u ? cnt : 1u;
}

__device__ __forceinline__ void xcd_barrier(const XcdBarrier& b, int tid_in) {
    const int tid_b = tid_in;
    asm volatile("s_waitcnt vmcnt(0)" ::: "memory");
    __syncthreads();
    if (tid_b == 0) {
        unsigned* bar = b.bar;
        __builtin_amdgcn_s_waitcnt(0);
        unsigned nloc = b.st[0], nx = b.st[1];
        if (nloc == 0u) { xcd_barrier_complete(bar, b.x, nloc, nx); b.st[0] = nloc; b.st[1] = nx; }
        const unsigned old = xb_add(&bar[XB_XSUB(b.x)], 1u);
        const unsigned gen = old / nloc;
        if (old + 1u == (gen + 1u) * nloc) {
            __builtin_amdgcn_fence(__ATOMIC_RELEASE, "agent");
            asm volatile("s_waitcnt vmcnt(0)" ::: "memory");
            const unsigned og = xb_add(&bar[XB_TOP], 1u);
            const unsigned tg = og / nx;
            if (og + 1u == (tg + 1u) * nx) xb_add(&bar[XB_TOPGEN], 1u);
            else XB_SPIN(xb_ld(&bar[XB_TOPGEN]) == tg, bar);
            __builtin_amdgcn_fence(__ATOMIC_ACQUIRE, "agent");
            xb_add(&bar[XB_XGEN(b.x)], 1u);
            asm volatile("s_waitcnt vmcnt(0)" ::: "memory");
        } else {
            XB_SPIN(xb_ld(&bar[XB_XGEN(b.x)]) == gen, bar);
            __builtin_amdgcn_fence(__ATOMIC_ACQUIRE, "agent");
            asm volatile("s_waitcnt vmcnt(0)" ::: "memory");
        }
    }
    __syncthreads();
}

__device__ __forceinline__ float wave_sum(float v) {
#pragma unroll
    for (int o = 1; o < 64; o <<= 1) v += __shfl_xor(v, o);
    return v;
}
__device__ __forceinline__ int inproj_row(int c, int odd) {
    int t, hd; const int d = c & 63;
    if (odd) { t = c >> 10; hd = (c >> 6) & 15; }
    else { const int seg = c >> 9; t = seg % 3; hd = ((c >> 6) & 7) + 8 * (seg / 3); }
    const int ca = t * 1024 + hd * 64;
    return (ca & ~255) + 128 * (d >> 5) + 32 * (hd & 3);
}
__device__ __forceinline__ unsigned cvtpk_h(float lo, float hi) { unsigned r; asm volatile("v_cvt_pk_bf16_f32 %0, %1, %2" : "=v"(r) : "v"(lo), "v"(hi)); return r; }
__device__ __forceinline__ void transpose_item(const float* W, int ldw, int K, int k0, int n0, bf16* WT, int prow0, int prow1, const float* g, LAS float* scr, int lane) {
    const int n4 = lane & 15, kq = lane >> 4;
    f32x4 x[16];
#pragma unroll
    for (int i = 0; i < 16; ++i) x[i] = __builtin_nontemporal_load((const f32x4*)(W + (size_t)(k0 + kq + 4 * i) * ldw + n0 + 4 * n4));
#pragma unroll
    for (int i = 0; i < 16; ++i) { const int kk = kq + 4 * i; const float gs = g ? g[k0 + kk] : 1.0f;
#pragma unroll
        for (int e_ = 0; e_ < 4; ++e_) scr[(4 * n4 + e_) * 65 + kk] = x[i][e_] * gs; }
    LDS_WAIT(); asm volatile("" ::: "memory");
    const int c = lane & 7;
#pragma unroll
    for (int i = 0; i < 8; ++i) { const int n = (lane >> 3) + 8 * i; const LAS float* s = scr + n * 65 + 8 * c;
        v4u o; o.x = cvtpk_h(s[0], s[1]); o.y = cvtpk_h(s[2], s[3]); o.z = cvtpk_h(s[4], s[5]); o.w = cvtpk_h(s[6], s[7]);
        *(GAS v4u*)(WT + (size_t)((n < 32 ? prow0 + n : prow1 + n - 32)) * K + k0 + 8 * c) = o; }
    LDS_WAIT(); asm volatile("" ::: "memory");
}

__device__ __forceinline__ void transpose_item3(const float* W, int ldw, int K, int k0, int n0, bf16* WT, int prow0, int prow1, int prow2, int prow3, const float* g, LAS unsigned* scr, int lane) {
    const int n4 = lane & 31, kq = lane >> 5;
#pragma unroll
    for (int hh = 0; hh < 2; ++hh) {
        f32x4 xa[8], xb[8];
#pragma unroll
        for (int m = 0; m < 8; ++m) { const int ka = 4 * (8 * hh + m) + 2 * kq; const float* src = W + (size_t)(k0 + ka) * ldw + n0 + 4 * n4;
            xa[m] = __builtin_nontemporal_load((const f32x4*)src); xb[m] = __builtin_nontemporal_load((const f32x4*)(src + ldw)); }
#pragma unroll
        for (int m = 0; m < 8; ++m) { const int ka = 4 * (8 * hh + m) + 2 * kq; const float ga = g ? g[k0 + ka] : 1.0f, gb = g ? g[k0 + ka + 1] : 1.0f;
#pragma unroll
            for (int e_ = 0; e_ < 4; ++e_) scr[(4 * n4 + e_) * 33 + (ka >> 1)] = cvtpk_h(xa[m][e_] * ga, xb[m][e_] * gb); }
    }
    LDS_WAIT(); asm volatile("" ::: "memory");
    const int c = lane & 7;
#pragma unroll
    for (int i = 0; i < 16; ++i) { const int n = (lane >> 3) + 8 * i; const LAS unsigned* s = scr + n * 33 + 4 * c;
        v4u o; o.x = s[0]; o.y = s[1]; o.z = s[2]; o.w = s[3];
        const int pr = (i < 4) ? prow0 : (i < 8) ? prow1 : (i < 12) ? prow2 : prow3;
        *(GAS v4u*)(WT + (size_t)(pr + (n & 31)) * K + k0 + 8 * c) = o; }
    LDS_WAIT(); asm volatile("" ::: "memory");
}
#ifndef PRO_T3
#define PRO_T3 0
#endif
__device__ __forceinline__ void transpose_item2(const float* W, int ldw, int K, int k0, int n0, bf16* WT, int prow, const float* g, LAS float* scr, int lane) {
    const int n4 = lane & 7, kq = lane >> 3;
    f32x4 x[16];
#pragma unroll
    for (int i = 0; i < 16; ++i) x[i] = __builtin_nontemporal_load((const f32x4*)(W + (size_t)(k0 + kq + 8 * i) * ldw + n0 + 4 * n4));
#pragma unroll
    for (int i = 0; i < 16; ++i) { const int kk = kq + 8 * i; const float gs = g ? g[k0 + kk] : 1.0f;
#pragma unroll
        for (int e_ = 0; e_ < 4; ++e_) scr[(4 * n4 + e_) * 129 + kk] = x[i][e_] * gs; }
    LDS_WAIT(); asm volatile("" ::: "memory");
    const int c = lane & 15;
#pragma unroll
    for (int i = 0; i < 8; ++i) { const int n = (lane >> 4) + 4 * i; const LAS float* s = scr + n * 129 + 8 * c;
        v4u o; o.x = cvtpk_h(s[0], s[1]); o.y = cvtpk_h(s[2], s[3]); o.z = cvtpk_h(s[4], s[5]); o.w = cvtpk_h(s[6], s[7]);
        *(GAS v4u*)(WT + (size_t)(prow + n) * K + k0 + 8 * c) = o; }
    LDS_WAIT(); asm volatile("" ::: "memory");
}
#ifndef PRO_T2
#define PRO_T2 0
#endif
#ifndef PRO_ORDER
#define PRO_ORDER 1
#endif
#define PRO_DECODE(r, KB, NB, kb, nb) do { if (PRO_ORDER == 0) { kb = (r) / (NB); nb = (r) % (NB); } else if (PRO_ORDER == 1) { kb = (r) % (KB); nb = (r) / (KB); } \
    else { const int q_ = (r) >> 3, i_ = (r) & 7; kb = 4 * (q_ % ((KB) / 4)) + (i_ & 3); nb = 2 * (q_ / ((KB) / 4)) + (i_ >> 2); } } while (0)
#ifndef PRO_KFAST
#define PRO_KFAST 1
#endif
#ifndef PROBE_PRO_W
#define PROBE_PRO_W 1
#endif
#ifndef PROBE_PRO_S
#define PROBE_PRO_S 1
#endif
struct Args { const float* in[27]; float* out; unsigned char* ws; int ph_lo, ph_hi; };

template <class T> __device__ __forceinline__ T* as_global(T* p) { return (T*)(GAS T*)p; }
typedef const __attribute__((address_space(4))) Args* KArgs;
__device__ __forceinline__ void convert_inputs(KArgs Ak, LAS unsigned char* lds, int gw, int NGW, int wave, int lane_in, int Llo, int Lhi, bool do_x, bool do_band, int sel = -1  ) {
    int lane = lane_in; asm volatile("" : "+v"(lane));
    LAS float* scr = (LAS float*)(lds + wave * 16896);
#define AIN(i) as_global(Ak->in[i])
    unsigned char* ws = as_global(Ak->ws);
    constexpr int TD_ = PRO_T3 ? 2 : 1;
    constexpr int I_IN = 16 * 48 / TD_, I_OUT = 16 * 16 / TD_, I_F1 = 16 * 64 / TD_, I_F2 = 64 * 16 / TD_, I_G = 16 * 16 / TD_, I_PP = 4 * 16 / TD_;
    constexpr int PER_LAYER = I_IN + I_OUT + I_F1 + I_F2 + I_G + I_PP;
    for (int pw_ = 0; pw_ < PROBE_PRO_W; ++pw_)
    for (int it = Llo * PER_LAYER + gw; it < Lhi * PER_LAYER; it += NGW) {
        const int L = it / PER_LAYER; int r = it % PER_LAYER; const int odd = L & 1, j = L >> 1;
        if (sel >= 0 && !((sel >> ((r < I_IN) ? L : 4 + L)) & 1)) continue;
#if PRO_T3
        LAS unsigned* scr3 = (LAS unsigned*)(lds + wave * 16896);
#define T3_ID(n0_) (n0_), (n0_) + 32, (n0_) + 64, (n0_) + 96
        if (r < I_IN) { const int kb = r % 16, nb = r / 16; const int ldw = odd ? 3088 : 3072;
            const float* w16_ = AIN(16); const float* w12_ = AIN(12); const float* W = (odd ? w16_ : w12_) + (size_t)j * 1024 * ldw;
            transpose_item3(W, ldw, 1024, 64 * kb, 128 * nb, (bf16*)(ws + WS_WIN + L * WIN_STRIDE), inproj_row(128 * nb, odd), inproj_row(128 * nb + 32, odd), inproj_row(128 * nb + 64, odd), inproj_row(128 * nb + 96, odd), AIN(11) + L * 1024, scr3, lane); continue; }
        r -= I_IN;
        if (r < I_OUT) { const int kb = r % 16, nb = r / 16; transpose_item3(AIN(20) + (size_t)L * 1024 * 1024, 1024, 1024, 64 * kb, 128 * nb, (bf16*)(ws + WS_WOUT) + (size_t)L * 1024 * 1024, T3_ID(128 * nb), nullptr, scr3, lane); continue; }
        r -= I_OUT;
        if (r < I_F1) { const int kb = r % 16, nb = r / 16; transpose_item3(AIN(22) + (size_t)L * 1024 * 4096, 4096, 1024, 64 * kb, 128 * nb, (bf16*)(ws + WS_WFF1) + (size_t)L * 4096 * 1024, T3_ID(128 * nb), AIN(21) + L * 1024, scr3, lane); continue; }
        r -= I_F1;
        if (r < I_F2) { const int kb = r % 64, nb = r / 64; transpose_item3(AIN(23) + (size_t)L * 4096 * 1024, 1024, 4096, 64 * kb, 128 * nb, (bf16*)(ws + WS_WFF2) + (size_t)L * 1024 * 4096, T3_ID(128 * nb), nullptr, scr3, lane); continue; }
        r -= I_F2;
        if (r < I_G) { const int kb = r % 16, nb = r / 16; transpose_item3(AIN(25) + (size_t)L * 1024 * 1024, 1024, 1024, 64 * kb, 128 * nb, (bf16*)(ws + WS_WG) + (size_t)L * 1024 * 1024, T3_ID(128 * nb), AIN(24) + L * 1024, scr3, lane); continue; }
        r -= I_G;
        { const int kb = r % 4, nb = r / 4; transpose_item3(AIN(26) + (size_t)L * 256 * 1024, 1024, 256, 64 * kb, 128 * nb, (bf16*)(ws + WS_WPP) + (size_t)L * 1024 * 256, T3_ID(128 * nb), nullptr, scr3, lane); }
#elif PRO_T2
        if (r < I_IN) { const int kb = r % 8, nb = r / 8; const int ldw = odd ? 3088 : 3072;
            const float* w16_ = AIN(16); const float* w12_ = AIN(12); const float* W = (odd ? w16_ : w12_) + (size_t)j * 1024 * ldw;
            transpose_item2(W, ldw, 1024, 128 * kb, 32 * nb, (bf16*)(ws + WS_WIN + L * WIN_STRIDE), inproj_row(32 * nb, odd), AIN(11) + L * 1024, scr, lane); continue; }
        r -= I_IN;
        if (r < I_OUT) { const int kb = r % 8, nb = r / 8; transpose_item2(AIN(20) + (size_t)L * 1024 * 1024, 1024, 1024, 128 * kb, 32 * nb, (bf16*)(ws + WS_WOUT) + (size_t)L * 1024 * 1024, 32 * nb, nullptr, scr, lane); continue; }
        r -= I_OUT;
        if (r < I_F1) { const int kb = r % 8, nb = r / 8; transpose_item2(AIN(22) + (size_t)L * 1024 * 4096, 4096, 1024, 128 * kb, 32 * nb, (bf16*)(ws + WS_WFF1) + (size_t)L * 4096 * 1024, 32 * nb, AIN(21) + L * 1024, scr, lane); continue; }
        r -= I_F1;
        if (r < I_F2) { const int kb = r % 32, nb = r / 32; transpose_item2(AIN(23) + (size_t)L * 4096 * 1024, 1024, 4096, 128 * kb, 32 * nb, (bf16*)(ws + WS_WFF2) + (size_t)L * 1024 * 4096, 32 * nb, nullptr, scr, lane); continue; }
        r -= I_F2;
        if (r < I_G) { const int kb = r % 8, nb = r / 8; transpose_item2(AIN(25) + (size_t)L * 1024 * 1024, 1024, 1024, 128 * kb, 32 * nb, (bf16*)(ws + WS_WG) + (size_t)L * 1024 * 1024, 32 * nb, AIN(24) + L * 1024, scr, lane); continue; }
        r -= I_G;
        { const int kb = r % 2, nb = r / 2; transpose_item2(AIN(26) + (size_t)L * 256 * 1024, 1024, 256, 128 * kb, 32 * nb, (bf16*)(ws + WS_WPP) + (size_t)L * 1024 * 256, 32 * nb, nullptr, scr, lane); }
#else
        if (r < I_IN) { int kb, nb; PRO_DECODE(r, 16, 48, kb, nb); const int ldw = odd ? 3088 : 3072;
            const float* w16_ = AIN(16); const float* w12_ = AIN(12); const float* W = (odd ? w16_ : w12_) + (size_t)j * 1024 * ldw;
            transpose_item(W, ldw, 1024, 64 * kb, 64 * nb, (bf16*)(ws + WS_WIN + L * WIN_STRIDE), inproj_row(64 * nb, odd), inproj_row(64 * nb + 32, odd), AIN(11) + L * 1024, scr, lane); continue; }
        r -= I_IN;
        if (r < I_OUT) { int kb, nb; PRO_DECODE(r, 16, 16, kb, nb); transpose_item(AIN(20) + (size_t)L * 1024 * 1024, 1024, 1024, 64 * kb, 64 * nb, (bf16*)(ws + WS_WOUT) + (size_t)L * 1024 * 1024, 64 * nb, 64 * nb + 32, nullptr, scr, lane); continue; }
        r -= I_OUT;
        if (r < I_F1) { int kb, nb; PRO_DECODE(r, 16, 64, kb, nb); transpose_item(AIN(22) + (size_t)L * 1024 * 4096, 4096, 1024, 64 * kb, 64 * nb, (bf16*)(ws + WS_WFF1) + (size_t)L * 4096 * 1024, 64 * nb, 64 * nb + 32, AIN(21) + L * 1024, scr, lane); continue; }
        r -= I_F1;
        if (r < I_F2) { int kb, nb; PRO_DECODE(r, 64, 16, kb, nb); transpose_item(AIN(23) + (size_t)L * 4096 * 1024, 1024, 4096, 64 * kb, 64 * nb, (bf16*)(ws + WS_WFF2) + (size_t)L * 1024 * 4096, 64 * nb, 64 * nb + 32, nullptr, scr, lane); continue; }
        r -= I_F2;
        if (r < I_G) { int kb, nb; PRO_DECODE(r, 16, 16, kb, nb); transpose_item(AIN(25) + (size_t)L * 1024 * 1024, 1024, 1024, 64 * kb, 64 * nb, (bf16*)(ws + WS_WG) + (size_t)L * 1024 * 1024, 64 * nb, 64 * nb + 32, AIN(24) + L * 1024, scr, lane); continue; }
        r -= I_G;
        { int kb, nb; PRO_DECODE(r, 4, 16, kb, nb); transpose_item(AIN(26) + (size_t)L * 256 * 1024, 1024, 256, 64 * kb, 64 * nb, (bf16*)(ws + WS_WPP) + (size_t)L * 1024 * 256, 64 * nb, 64 * nb + 32, nullptr, scr, lane); }
#endif
    }
    for (int it = gw; it < 2 * 256 * 2; it += NGW) {
        const int j = it >> 9, row = (it >> 1) & 255, k = (it & 1) * 512 + lane * 8, L = 2 * j + 1;
        if (L < Llo || L >= Lhi) continue;
        if (sel >= 0 && !((sel >> L) & 1)) continue;
        v4u o = (v4u){0u, 0u, 0u, 0u};
        if (row < 16) { const float* W = AIN(16) + (size_t)j * 1024 * 3088 + 3072 + row; const float* g = AIN(11) + L * 1024; float v[8];
#pragma unroll
            for (int i = 0; i < 8; ++i) v[i] = W[(size_t)(k + i) * 3088] * g[k + i];
            o.x = cvtpk_h(v[0], v[1]); o.y = cvtpk_h(v[2], v[3]); o.z = cvtpk_h(v[4], v[5]); o.w = cvtpk_h(v[6], v[7]); }
        *(GAS v4u*)((bf16*)(ws + WS_WIN + L * WIN_STRIDE) + (size_t)(3072 + row) * 1024 + k) = o;
    }
    for (int ps2_ = 0; ps2_ < PROBE_PRO_S; ++ps2_)
    for (int it = Llo * (MROWS * 256 / 2048) + gw; it < Lhi * (MROWS * 256 / 2048); it += NGW) {
        if (sel >= 0 && !((sel >> (8 + it / (MROWS * 256 / 2048))) & 1)) continue;
        f32x4 a[4], b[4]; size_t e[4];
#pragma unroll
        for (int q = 0; q < 4; ++q) { e[q] = (size_t)it * 2048 + q * 512 + lane * 8; const int i = (int)(e[q] / ((size_t)MROWS * 256)); const size_t rem = e[q] % ((size_t)MROWS * 256); const int row = (int)(rem >> 8), c = (int)(rem & 255);
            const float* p9_ = AIN(9); const float* p10_ = AIN(10); const float* src = (row < SEQ) ? p9_ + ((size_t)i * SEQ + row) * 256 + c : p10_ + ((size_t)i * NSMP + (row - SEQ)) * 256 + c;
            a[q] = __builtin_nontemporal_load((const f32x4*)src); b[q] = __builtin_nontemporal_load((const f32x4*)(src + 4)); }
#pragma unroll
        for (int q = 0; q < 4; ++q) { v4u o; o.x = cvtpk_h(a[q][0], a[q][1]); o.y = cvtpk_h(a[q][2], a[q][3]); o.z = cvtpk_h(b[q][0], b[q][1]); o.w = cvtpk_h(b[q][2], b[q][3]);
            *(GAS v4u*)((bf16*)(ws + WS_PB) + e[q]) = o; }
    }
    if (do_x)
    for (int ps3_ = 0; ps3_ < PROBE_PRO_S; ++ps3_)
    for (int rp = gw; rp < MROWS / 2; rp += NGW) {
        f32x4 v[2][4];
#pragma unroll
        for (int h2 = 0; h2 < 2; ++h2) { const int row = 2 * rp + h2; const float* x0_ = AIN(0); const float* x1_ = AIN(1); const float* xr = (row < SEQ) ? x0_ + (size_t)row * DM : x1_ + (size_t)(row - SEQ) * DM;
#pragma unroll
            for (int q = 0; q < 4; ++q) v[h2][q] = __builtin_nontemporal_load((const f32x4*)xr + lane + 64 * q); }
#pragma unroll
        for (int h2 = 0; h2 < 2; ++h2) { const int row = 2 * rp + h2; float s = 0.f;
#pragma unroll
            for (int q = 0; q < 4; ++q) s += (v[h2][q][0] * v[h2][q][0] + v[h2][q][1] * v[h2][q][1]) + (v[h2][q][2] * v[h2][q][2] + v[h2][q][3] * v[h2][q][3]);
            s = wave_sum(s);
            GAS unsigned long long* o8 = (GAS unsigned long long*)((bf16*)(ws + WS_HB0) + (size_t)row * DM) + lane;
#pragma unroll
            for (int q = 0; q < 4; ++q) o8[64 * q] = (unsigned long long)cvtpk_h(v[h2][q][0], v[h2][q][1]) | ((unsigned long long)cvtpk_h(v[h2][q][2], v[h2][q][3]) << 32);
            if (lane < 16) ((float*)(ws + WS_SSQ0))[(size_t)row * 16 + lane] = (lane == 0) ? s : 0.f; }
    }
    constexpr int CH4 = 496 * 512 / 4;
    if (do_band)
    for (int ps4_ = 0; ps4_ < PROBE_PRO_S; ++ps4_)
    for (int it = gw; it < 2 * 2 * 16 * (CH4 / 512); it += NGW) {
        const int chunk = it / (CH4 / 512), part = it % (CH4 / 512); const int tz = chunk >> 5, jb = chunk & 31;
        const float* c5_ = AIN(5); const float* c4_ = AIN(4); const f32x4* src = (const f32x4*)((tz ? c5_ : c4_) + (size_t)jb * 512 * 512 + 16 * 512) + (size_t)part * 512 + lane;
        f32x4* dst = (f32x4*)(as_global(Ak->out) + (tz ? O_SBV : O_SBK) + (size_t)jb * 512 * 512) + (size_t)part * 512 + lane;
        f32x4 t[8];
#pragma unroll
        for (int q = 0; q < 8; ++q) t[q] = __builtin_nontemporal_load(src + 64 * q);
#pragma unroll
        for (int q = 0; q < 8; ++q) __builtin_nontemporal_store(t[q], dst + 64 * q);
    }
}
#undef AIN

__device__ __forceinline__ void scan_seq(const float* src0, int n0, const float* src1, int n1, double* dst, LAS unsigned char* lds, int tid_in) {
    int tid = tid_in; asm volatile("" : "+v"(tid));
    LAS double* wsum = (LAS double*)lds;
    const int n = n0 + n1, chunk = (n + 511) / 512, s0 = tid * chunk; int cnt = n - s0; cnt = cnt < 0 ? 0 : (cnt > chunk ? chunk : cnt);
    float x[32];
#pragma unroll
    for (int i = 0; i < 32; ++i) { const int s = s0 + i; const float* p = (s < n0) ? src0 + (size_t)s * 16 : src1 + (size_t)(s - n0) * 16; x[i] = (i < cnt) ? *p : 0.f; }
    double acc = 0.0;
#pragma unroll
    for (int i = 0; i < 32; ++i) acc += (double)x[i];
    const int lane = tid & 63, w = tid >> 6;
    double inc = acc;
#pragma unroll
    for (int o = 1; o < 64; o <<= 1) { const double t = __shfl_up(inc, o); if (lane >= o) inc += t; }
    if (lane == 63) wsum[w] = inc;
    __syncthreads();
    double base = 0.0;
#pragma unroll
    for (int ww = 0; ww < 8; ++ww) if (ww < w) base += wsum[ww];
    double run = base + inc - acc;
#pragma unroll
    for (int i = 0; i < 32; ++i) { run += (double)x[i]; if (i < cnt) dst[s0 + i] = run; }
    __syncthreads();
}

#ifndef DEFER_L1
#define DEFER_L1 0
#endif
#ifndef FOX_THRL
#define FOX_THRL 8
#endif
#ifndef PG8_SP2
#define PG8_SP2 true
#endif
#ifndef PG8_ALIGN_IN
#define PG8_ALIGN_IN true
#endif
#ifndef PG8_ALIGN_FF1
#define PG8_ALIGN_FF1 true
#endif
#ifndef N_DEFER_UNITS
#define N_DEFER_UNITS 512
#endif
#ifndef PROBE_REP_PA
#define PROBE_REP_PA 1
#endif
#ifndef PROBE_REP_PB
#define PROBE_REP_PB 1
#endif
#ifndef PROBE_FILL
#define PROBE_FILL 1
#endif
#ifndef PROBE_REP_SMPC
#define PROBE_REP_SMPC 1
#endif
#ifndef SMP_RATIO
#define SMP_RATIO 3
#endif
#ifndef FF2_ST
#define FF2_ST 8
#endif
#ifndef EXP_REBALANCE
#define EXP_REBALANCE 1
#endif
#ifndef EXP_OVERLAP
#define EXP_OVERLAP 0
#endif
#ifndef PP_EARLY
#define PP_EARLY 0
#endif
#ifndef STICK_PRE
#define STICK_PRE 1
#endif
#ifndef XCDQ
#define XCDQ 0
#endif
#ifndef STATIC_FIRST
#define STATIC_FIRST 0
#endif
#ifndef FILL_SPREAD
#define FILL_SPREAD 1
#endif
#ifndef DEFER_SPLIT
#define DEFER_SPLIT 1
#endif
#ifndef EVEN_PARITY
#define EVEN_PARITY 1
#endif
#ifndef L0_CONV
#define L0_CONV 1
#endif
#ifndef TICKET_PREFETCH
#define TICKET_PREFETCH 0
#endif
#ifndef PROBE_REP_SMPE
#define PROBE_REP_SMPE 1
#endif
#ifndef PROBE_REP_EXPE
#define PROBE_REP_EXPE 1
#endif
#ifndef DBASE_OFF
#define DBASE_OFF 118784
#endif
#ifndef PROBE_REP_SCAN
#define PROBE_REP_SCAN 1
#endif
#ifndef PROBE_REP_BAR
#define PROBE_REP_BAR 1
#endif
#ifndef SKIP_BASE
#define SKIP_BASE 160.0f
#endif
#ifndef RES_OUT
#define RES_OUT residual16<4>
#endif
#ifndef BAND_ON_FOX
#define BAND_ON_FOX 1
#endif
#ifndef PROBE_REP_SMMIN
#define PROBE_REP_SMMIN 1
#endif
#ifndef PROBE_REP_SMM
#define PROBE_REP_SMM 1
#endif
#ifndef PROBE_REP_PRO
#define PROBE_REP_PRO 1
#endif
#ifndef PROBE_REP_IN
#define PROBE_REP_IN 1
#endif
#ifndef PROBE_REP_OUT
#define PROBE_REP_OUT 1
#endif
#ifndef PROBE_REP_FF1
#define PROBE_REP_FF1 1
#endif
#ifndef PROBE_REP_FF2
#define PROBE_REP_FF2 1
#endif
#ifndef PROBE_REP_PLE
#define PROBE_REP_PLE 1
#endif
#ifndef PROBE_ATT_REP
#define PROBE_ATT_REP 1
#define PROBE_ATT_PAR 0
#endif
#ifndef SKIP_IN
#define SKIP_IN 0
#endif
#ifndef SKIP_OUT
#define SKIP_OUT 0
#endif
#ifndef SKIP_FF1
#define SKIP_FF1 0
#endif
#ifndef SKIP_FF2
#define SKIP_FF2 0
#endif
#ifndef SKIP_PLE
#define SKIP_PLE 0
#endif
constexpr int N_PHASES = 1 + 7 * DEPTH;
__global__ void __launch_bounds__(NWAVES * 64, 2) fwd_kernel(Args args) {
    extern __shared__ __attribute__((aligned(16))) unsigned char lds_raw[];
    LAS unsigned char* lds = (LAS unsigned char*)lds_raw;
    volatile LAS unsigned* MISC = (volatile LAS unsigned*)(lds + MISC_OFF);
    const int tid0 = threadIdx.x, G0 = gridDim.x, bx0 = blockIdx.x; const int wave0 = __builtin_amdgcn_readfirstlane(tid0 >> 6);
    for (int u = tid0; u < (LDS_BYTES - MISC_OFF) / 4; u += NWAVES * 64) ((LAS unsigned*)(lds + MISC_OFF))[u] = 0u;
    __syncthreads();
    KArgs kp0 = (KArgs)__builtin_amdgcn_kernarg_segment_ptr();
    unsigned char* ws = args.ws;
    XcdBarrier bar; bar.bar = (unsigned*)(ws + WS_CTL) + CW_BAR; bar.x = 0; bar.st = nullptr;
    if (!N_LAUNCH_PER_PHASE) bar = xcd_barrier_post((unsigned*)(ws + WS_CTL) + CW_BAR, MISC + 8);
#define PHASE_IDS int wv_ = wave0; asm volatile("" : "+s"(wv_)); int ln_; asm volatile("v_mbcnt_lo_u32_b32 %0, -1, 0\n\tv_mbcnt_hi_u32_b32 %0, -1, %0" : "=v"(ln_)); \
    const int tid = wv_ * 64 + ln_, lane = ln_, wave = wv_; (void)lane; (void)wave
#define GRID_BAR() do { if (!N_LAUNCH_PER_PHASE) { XcdBarrier b_ = bar; asm volatile("" : "+s"(b_.bar), "+s"(b_.x)); b_.bar = (unsigned*)(GAS unsigned*)b_.bar; int bw_ = wave0; asm volatile("" : "+s"(bw_)); int bl_; asm volatile("v_mbcnt_lo_u32_b32 %0, -1, 0\n\tv_mbcnt_hi_u32_b32 %0, -1, %0" : "=v"(bl_)); for (int pbar_ = 0; pbar_ < PROBE_REP_BAR; ++pbar_) xcd_barrier(b_, bw_ * 64 + bl_); } } while (0)
    const int lo = args.ph_lo, hi = args.ph_hi;
#define IN(k) (lo <= (k) && (k) < hi)
#define BOTH(k) (IN(k) && ((k) + 1 < hi))

#ifndef SKIP_PRO
    for (int rp_ = 0; rp_ < PROBE_REP_PRO; ++rp_)
    if (IN(0)) { const int vcu = (G0 % 8 == 0) ? (bx0 % 8) * (G0 / 8) + bx0 / 8 : bx0; convert_inputs(kp0, lds, vcu * NWAVES + wave0, G0 * NWAVES, wave0, tid0 & 63, 0, (N_DEFER_UNITS > 0) ? (DEFER_L1 ? 1 : 2) : DEPTH, true, N_DEFER_UNITS == 0, DEFER_SPLIT ? (L0_CONV ? 0x003 : 0x113) : -1); if (BOTH(0)) GRID_BAR(); }
#endif

    for (int L = 0; L < DEPTH; ++L) {
        const int pb = 1 + 7 * L, odd = L & 1, j = L >> 1, cur = L & 1;
        int bx = bx0, G = G0; asm volatile("" : "+s"(bx), "+s"(G));
        KArgs kp = kp0; asm volatile("" : "+s"(kp));
        unsigned char* ws = as_global(kp->ws); float* out = as_global(kp->out); float* Y = out + O_Y;
        bf16* Qb = (bf16*)(ws + WS_Q); bf16* Kb = (bf16*)(ws + WS_K); bf16* Vb = (bf16*)(ws + WS_V); bf16* Ob = (bf16*)(ws + WS_O); bf16* HID = (bf16*)(ws + WS_HID); bf16* PP = (bf16*)(ws + WS_PP);
        double* Dp = (double*)(ws + WS_DP); double* Ds = (double*)(ws + WS_DS);
        bf16* HBc = (bf16*)(ws + (cur ? WS_HB1 : WS_HB0)); bf16* HBn = (bf16*)(ws + (cur ? WS_HB0 : WS_HB1));
        float* SSc = (float*)(ws + (cur ? WS_SSQ1 : WS_SSQ0)); float* SSn = (float*)(ws + (cur ? WS_SSQ0 : WS_SSQ1));
        for (int pr_ = PROBE_REP_IN; pr_ > 0; --pr_)
        if (!SKIP_IN && IN(pb)) {
            PHASE_IDS;
            const bf16* Win_ = (const bf16*)(ws + WS_WIN + L * WIN_STRIDE);
            pg8::Gemm g{HBc, Win_, SEQ, 3072, DM}; pg8::StaticOrder S; S.init(SEQ, 3072, G, bx);
            const float* gq_ = (odd ? as_global(kp->in[18]) : as_global(kp->in[13])) + j * 64; const float* gk_ = (odd ? as_global(kp->in[19]) : as_global(kp->in[14])) + j * 64;
            for (int ps_ = 0; ps_ < PROBE_REP_SMM * PROBE_REP_SMMIN; ++ps_) smm::in_proj(HBc, Win_, SSc, Qb, out, gq_, gk_, as_global(kp->in[17]) + j * 16, odd, j, (float*)(ws + WS_DP), (double*)(ws + WS_TT), lds, bx, G, tid);
            pg8::EpiIn E{SSc, Qb, out, gq_, (long long)((const char*)gk_ - (const char*)gq_), odd, j};
            pg8::gemm_phase<pg8::EpiIn, pg8::StaticOrder, PG8_ALIGN_IN, PG8_SP2>(lds + RING_OFF, g, S, E, tid);
            if (BOTH(pb)) GRID_BAR();
        }
#ifndef SKIP_ATT
        for (int rep_ = 0; rep_ < ((PROBE_ATT_REP > 1 && odd == PROBE_ATT_PAR) ? PROBE_ATT_REP : 1); ++rep_)
        if (IN(pb + 2)) {
            PHASE_IDS;
            const att::bf16 *Qg = Qb, *Kg = Kb, *Vg = Vb; att::bf16* Og = Ob;
            if (!odd) {
                for (int pa_ = 0; pa_ < PROBE_REP_PA; ++pa_)
                for (int x = bx * 8 + wave; x < 4096; x += 8 * G) att::stick_wave_unit(x & 7, x >> 3, Qg, Kg, Vg, Og, lds + wave * att::SW_BYTES, lane);
#if L0_CONV
                if (L == 0) convert_inputs(kp0, lds, bx * NWAVES + wave, G * NWAVES, wave, lane, 0, 1, false, false, 0x110);
#endif
                __syncthreads();
#if EVEN_PARITY
                const bool memfirst_ = (G == 256) && (bx & 1);
#define EVEN_MEM_STAGE() do { if (G == 256) { if (bx < 128) smm::expand_kv(bx, Kb, out, 0, j, tid); else for (int i_ = 0; i_ < 3; ++i_) smm::expand_kv(128 + (bx - 128) * 3 + i_, Kb, out, 0, j, tid); } } while (0)
                if (memfirst_) { EVEN_MEM_STAGE(); __syncthreads(); }
#endif
                for (int pb_ = 0; pb_ < PROBE_REP_PB; ++pb_)
                for (int u = bx; u < 512; u += G) {
#if BAND_ON_FOX
                    fox::band_unit<8>(8 + (u & 7), u >> 3, as_global(kp->in[15]) + (size_t)(j * 8 + (u & 7)) * 257, (const fox::bf16*)Qg, (const fox::bf16*)Kg, (const fox::bf16*)Vg, (fox::bf16*)Og, (__attribute__((address_space(3))) char*)lds, tid);
#else
                    att::prompt_unit<1>(8 + (u & 7), u >> 3, Qg, Kg, Vg, Og, lds, nullptr, as_global(kp->in[15]) + (size_t)(j * 8 + (u & 7)) * 257, tid);
#endif
                }
#if EVEN_PARITY
                if (!memfirst_) { __syncthreads(); EVEN_MEM_STAGE(); }
                __syncthreads();
#endif
#if EXP_OVERLAP
                if (G == 256) {
                    const int b = (bx & 127) >> 3, hl = bx & 7;
                    if (bx < 128) {
                        if (wave == 0) {
                            att::SmpSrc S{as_global(kp->in[2]) + (size_t)(j * 16 + b) * PAST * 512, as_global(kp->in[3]) + (size_t)(j * 16 + b) * PAST * 512, PAST, 8, hl, Kg + (size_t)(SEQ + b * 16) * DM + hl * 64, Vg + (size_t)(SEQ + b * 16) * DM + hl * 64};
                            att::sample_unit_wave<0>(S, b, hl, Qg, Og, lds, nullptr, lane);
                        } else { smm::expand_kv_even_waves(2 * bx, Kb, out, j, lane, wave - 1, 7); smm::expand_kv_even_waves(2 * bx + 1, Kb, out, j, lane, wave - 1, 7); }
                    } else {
                        att::SmpSrc S{as_global(kp->in[4]) + (size_t)(j * 16 + b) * BANDL * 512, as_global(kp->in[5]) + (size_t)(j * 16 + b) * BANDL * 512, BANDL, 8, hl, Kg + (size_t)(SEQ + b * 16) * DM + (8 + hl) * 64, Vg + (size_t)(SEQ + b * 16) * DM + (8 + hl) * 64};
                        att::sample_unit_split<1>(S, b, 8 + hl, Qg, Og, lds, nullptr, as_global(kp->in[15]) + (size_t)(j * 8 + hl) * 257, tid);
                        smm::expand_kv(2 * bx, Kb, out, 0, j, tid); smm::expand_kv(2 * bx + 1, Kb, out, 0, j, tid);
                    }
                } else
#endif
                {
                for (int pse_ = 0; pse_ < PROBE_REP_SMPE; ++pse_)
                for (int x = bx; x < 256; x += G) {
                    const int b = (x & 127) >> 3, hl = x & 7;
                    if (x < 128) {
#if STICK_PRE
                        { att::SmpSrc S{as_global(kp->in[2]) + (size_t)(j * 16 + b) * PAST * 512, as_global(kp->in[3]) + (size_t)(j * 16 + b) * PAST * 512, PAST, 8, hl, Kg + (size_t)(SEQ + b * 16) * DM + hl * 64, Vg + (size_t)(SEQ + b * 16) * DM + hl * 64};
                          att::sample_unit_stick_pre(S, b, hl, Qg, Og, lds, wave, lane); }
#else
                        if (wave == 0) {
                            att::SmpSrc S{as_global(kp->in[2]) + (size_t)(j * 16 + b) * PAST * 512, as_global(kp->in[3]) + (size_t)(j * 16 + b) * PAST * 512, PAST, 8, hl, Kg + (size_t)(SEQ + b * 16) * DM + hl * 64, Vg + (size_t)(SEQ + b * 16) * DM + hl * 64};
                            att::sample_unit_wave<0>(S, b, hl, Qg, Og, lds, nullptr, lane);
                        }
#endif
                        __syncthreads();
                    } else {
                        att::SmpSrc S{as_global(kp->in[4]) + (size_t)(j * 16 + b) * BANDL * 512, as_global(kp->in[5]) + (size_t)(j * 16 + b) * BANDL * 512, BANDL, 8, hl, Kg + (size_t)(SEQ + b * 16) * DM + (8 + hl) * 64, Vg + (size_t)(SEQ + b * 16) * DM + (8 + hl) * 64};
                        att::sample_unit_split<1>(S, b, 8 + hl, Qg, Og, lds, nullptr, as_global(kp->in[15]) + (size_t)(j * 8 + hl) * 257, tid);
                    }
                }
                if (!EVEN_PARITY || G != 256)
                for (int pxe_ = 0; pxe_ < PROBE_REP_EXPE; ++pxe_)
#if EXP_REBALANCE
                if (G == 256) {
                    if (bx < 128) smm::expand_kv(bx, Kb, out, 0, j, tid);
                    else for (int i_ = 0; i_ < 3; ++i_) smm::expand_kv(128 + (bx - 128) * 3 + i_, Kb, out, 0, j, tid);
                } else
#endif
                for (int u = bx; u < 512; u += G) smm::expand_kv(u, Kb, out, 0, j, tid);
                }
                __syncthreads();
                if (DEFER_L1 && N_DEFER_UNITS > 0 && L == 0) { convert_inputs(kp0, lds, bx * NWAVES + wave, G * NWAVES, wave, lane, 1, 2, false, false); __syncthreads(); }
            } else {
                float gqm = fabsf(as_global(kp->in[18])[j * 64 + lane]), gkm = fabsf(as_global(kp->in[19])[j * 64 + lane]);
#pragma unroll
                for (int o_ = 1; o_ < 64; o_ <<= 1) { gqm = fmaxf(gqm, __shfl_xor(gqm, o_)); gkm = fmaxf(gkm, __shfl_xor(gkm, o_)); }
                const float skip_thr = __int_as_float(__builtin_amdgcn_readfirstlane(__float_as_int(-(SKIP_BASE + 2.0f * 1.02f * (64.0f * 0.125f * LOG2E) * gqm * gkm))));
                unsigned* qctr = (unsigned*)(ws + WS_CTL) + CW_QUEUE + 64 * (L * 4 + rep_) * (XCDQ ? 8 : 1);
                const int nq_ = 224 + ((L == 1) ? 64 : 0); (void)nq_;
                volatile LAS int* qslot = (volatile LAS int*)(lds + MISC_OFF + 64);
                if (STATIC_FIRST && tid == 0) qslot[3] = 0;
                unsigned tk = 0;
                if (TICKET_PREFETCH && tid == 0) tk = __hip_atomic_fetch_add(qctr, 1u, __ATOMIC_RELAXED, __HIP_MEMORY_SCOPE_AGENT);
#if XCDQ
                static_assert(N_DEFER_UNITS == 512 && PROBE_FILL == 1 && SMP_RATIO == 4, "per-XCD queue layout");
                volatile LAS int* qoffp = (volatile LAS int*)(lds + MISC_OFF + 80);
                if (tid == 0) *qoffp = 0;
#endif
                for (;;) {
#if XCDQ
                    if (tid == 0) { const int qo0_ = *qoffp, qi0_ = ((int)__builtin_amdgcn_workgroup_id_x() + qo0_) & 7;
                        const unsigned tk_ = __hip_atomic_fetch_add(qctr + 64 * qi0_, 1u, __ATOMIC_RELAXED, __HIP_MEMORY_SCOPE_AGENT);
                        const bool ex_ = tk_ >= (unsigned)nq_; if (ex_) *qoffp = qo0_ + 1;
                        *qslot = ex_ ? (qo0_ == 7 ? -2 : -1) : (int)(tk_ | ((unsigned)qi0_ << 16)); }
                    __syncthreads();
                    const int w_ = __builtin_amdgcn_readfirstlane(*qslot);
                    __syncthreads();
                    if (w_ == -2) break;
                    if (w_ == -1) continue;
                    const int t_ = w_ & 0xffff, qi = w_ >> 16;
                    int u;
                    if (t_ >= 224) u = 1792 + (t_ - 224) * 8 + qi;
                    else if (t_ >= 160) u = 1280 + (t_ - 160) * 8 + qi;
                    else if (t_ < 128 && (t_ & 3) == 3) { const int si = t_ >> 2; u = ((si >> 1) * 16 + 2 * qi + (si & 1)) * 4 + 3; }
                    else { const int pi = (t_ < 128) ? t_ - (t_ >> 2) : t_ - 32; const int up_ = (pi >> 1) * 16 + 2 * qi + (pi & 1); u = (up_ < 768) ? up_ + up_ / 3 : up_ + 256; }
                    asm volatile("" : "+s"(u));
                    const int n_exp = 512 * PROBE_FILL;
#else
#if STATIC_FIRST
                    if (tid == 0) { const int nf_ = qslot[3]; qslot[3] = 1; *qslot = nf_ ? (int)(G + __hip_atomic_fetch_add(qctr, 1u, __ATOMIC_RELAXED, __HIP_MEMORY_SCOPE_AGENT)) : bx; }
#else
                    if (!TICKET_PREFETCH && tid == 0) tk = __hip_atomic_fetch_add(qctr, 1u, __ATOMIC_RELAXED, __HIP_MEMORY_SCOPE_AGENT);
                    if (tid == 0) *qslot = (int)tk;
#endif
                    __syncthreads();
#if FILL_SPREAD
                    static_assert(N_DEFER_UNITS == 512 && PROBE_FILL == 1, "filler interleave layout");
                    const int raw_ = __builtin_amdgcn_readfirstlane(*qslot);
                    __syncthreads();
                    const int n_exp = 512, n_def = (L == 1) ? 512 : 0;
                    int u;
                    if (L == 1) { if (raw_ >= 256 * 9) break; const int per_ = raw_ / 9, r_ = raw_ % 9;
                        if (r_ < 5) u = per_ * 5 + r_; else { const int f_ = per_ * 4 + (r_ - 5); u = 1280 + ((f_ & 1) ? 512 + (f_ >> 1) : (f_ >> 1)); } }
#if DEFER_SPLIT
                    else { if (raw_ >= 256 * 8) break; const int per_ = raw_ >> 3, r_ = raw_ & 7;
                        if (r_ < 5) u = per_ * 5 + r_; else u = 1280 + ((r_ == 7) ? 512 + per_ : per_ * 2 + (r_ - 5)); }
#else
                    else { if (raw_ >= 256 * 7) break; const int per_ = raw_ / 7, r_ = raw_ % 7;
                        if (r_ < 5) u = per_ * 5 + r_; else u = 1280 + per_ * 2 + (r_ - 5); }
#endif
                    asm volatile("" : "+s"(u));
                    (void)n_def;
#else
                    const int u = __builtin_amdgcn_readfirstlane(*qslot);
                    __syncthreads();
                    const int n_exp = 512 * PROBE_FILL, n_def = (L == 1) ? N_DEFER_UNITS : 0;
                    if (u >= 256 + 1024 + n_exp + n_def) break;
#endif
#endif
#if TICKET_PREFETCH
                    if (tid == 0) tk = __hip_atomic_fetch_add(qctr, 1u, __ATOMIC_RELAXED, __HIP_MEMORY_SCOPE_AGENT);
#endif
                    if (u >= 256 + 1024 + n_exp) {
#if DEFER_SPLIT
                        if (L == 1) convert_inputs(kp0, lds, (u - 1280 - n_exp) * NWAVES + wave, 512 * NWAVES, wave, lane, 1, 4, false, true, 0x66C);
                        else convert_inputs(kp0, lds, (u - 1280 - n_exp) * NWAVES + wave, 256 * NWAVES, wave, lane, 3, 4, false, false, 0x880);
#else
                        convert_inputs(kp0, lds, (u - 1280 - n_exp) * NWAVES + wave, (N_DEFER_UNITS > 0 ? N_DEFER_UNITS : 1) * NWAVES, wave, lane, 2, 4, false, true);
#endif
                        continue; }
                    if (u >= 256 + 1024) { smm::expand_kv((u - 1280) & 511, Kb, out, 1, j, tid); continue; }
                    const bool is_smp = (u < 256 * SMP_RATIO) && (u % SMP_RATIO == SMP_RATIO - 1); const int us = u / SMP_RATIO, up = (u < 256 * SMP_RATIO) ? u - u / SMP_RATIO : u - 256;
                    if (is_smp) { const int b = us >> 4, h = us & 15;
                        att::SmpSrc S{as_global(kp->in[6]) + (size_t)(j * 16 + b) * PAST * 1024, as_global(kp->in[7]) + (size_t)(j * 16 + b) * PAST * 1024, PAST, 16, h, Kg + (size_t)(SEQ + b * 16) * DM + h * 64, Vg + (size_t)(SEQ + b * 16) * DM + h * 64};
                        scan_seq(as_global(kp->in[8]) + ((size_t)(j * 16 + b) * PAST) * 16 + h, PAST, out + O_SCF + (size_t)(j * NSMP + b * 16) * 16 + h, 16, Ds + (size_t)us * (PAST + 16), lds, tid);
                        for (int pc_ = 0; pc_ < PROBE_REP_SMPC; ++pc_) att::sample_unit_split<2>(S, b, h, Qg, Og, lds, Ds + (size_t)us * (PAST + 16), nullptr, tid);
                    } else { const int v = up, qb = 63 - (v >> 4), h = v & 15; const float* LPh = (const float*)(ws + WS_DP) + (size_t)h * SEQ;
                        LAS double* dbase = (LAS double*)(lds + DBASE_OFF);
                        volatile LAS int* qcnt = (volatile LAS int*)(lds + MISC_OFF + 72);
                        if (wave == 0) { int ln_ = lane; asm volatile("" : "+v"(ln_));
                            const double* Th = (const double*)(ws + WS_TT) + h * 256 + 4 * ln_; const double t0_ = Th[0], t1_ = Th[1], t2_ = Th[2], t3_ = Th[3];
                            const float* LPl = LPh + 256 * ln_ + 63; const float l0_ = LPl[0], l1_ = LPl[64], l2_ = LPl[128], l3_ = LPl[192]; const float lq_ = LPh[256 * qb];
                            double inc = (t0_ + t1_) + (t2_ + t3_); const double tot = inc;
#pragma unroll
                            for (int o_ = 1; o_ < 64; o_ <<= 1) { const double t_ = __shfl_up(inc, o_); if (ln_ >= o_) inc += t_; }
                            const double ex = inc - tot, d1_ = ex + t0_, d2_ = ex + t0_ + t1_, d3_ = ex + t0_ + t1_ + t2_; dbase[4 * ln_] = ex; dbase[4 * ln_ + 1] = d1_; dbase[4 * ln_ + 2] = d2_; dbase[4 * ln_ + 3] = d3_;
                            const double dq_ = __shfl(ex, qb) + (double)lq_; const int nt = 4 * qb + 4;
                            const bool p0_ = (4 * ln_ < nt) && ((float)(dq_ - (ex + (double)l0_)) * LOG2E < skip_thr), p1_ = (4 * ln_ + 1 < nt) && ((float)(dq_ - (d1_ + (double)l1_)) * LOG2E < skip_thr);
                            const bool p2_ = (4 * ln_ + 2 < nt) && ((float)(dq_ - (d2_ + (double)l2_)) * LOG2E < skip_thr), p3_ = (4 * ln_ + 3 < nt) && ((float)(dq_ - (d3_ + (double)l3_)) * LOG2E < skip_thr);
                            const int c_ = (int)(__popcll(__ballot(p0_)) + __popcll(__ballot(p1_)) + __popcll(__ballot(p2_)) + __popcll(__ballot(p3_)));
                            if (ln_ == 0) *qcnt = c_; }
                        __syncthreads();
                        const int t_first = __builtin_amdgcn_readfirstlane(*qcnt);
                        fox::attn_unit<FOX_THRL>(0, h, qb, t_first & ~1, LPh, (const __attribute__((address_space(3))) double*)dbase, (const fox::bf16*)Qg, (const fox::bf16*)Kg, (const fox::bf16*)Vg, (fox::bf16*)Og, (__attribute__((address_space(3))) char*)lds, tid); }
                }
            }
#if PP_EARLY
            { __syncthreads(); PHASE_IDS; int kple = DPLE; asm volatile("" : "+s"(kple));
              pg8::Gemm g{(const bf16*)(ws + WS_PB) + (size_t)L * MROWS * DPLE, (const bf16*)(ws + WS_WPP) + (size_t)L * DM * DPLE, SEQ, DM, kple}; pg8::StaticOrder S; S.init(SEQ, DM, G, bx);
              pg8::EpiPP E{PP};
              pg8::gemm_phase<pg8::EpiPP, pg8::StaticOrder, true, PG8_SP2>(lds + RING_OFF, g, S, E, tid); }
#endif
            if (BOTH(pb + 2)) GRID_BAR();
        }
#endif
        for (int pr_ = PROBE_REP_OUT; pr_ > 0; --pr_)
        if (!SKIP_OUT && IN(pb + 3)) {
            PHASE_IDS;
            for (int ps_ = 0; ps_ < PROBE_REP_SMM; ++ps_) smm::RES_OUT(Ob, (const bf16*)(ws + WS_WOUT) + (size_t)L * DM * DM, DM, HBc, HBn, SSn, lds, bx, G, tid);
            pg8::Gemm g{Ob, (const bf16*)(ws + WS_WOUT) + (size_t)L * DM * DM, SEQ, DM, DM}; pg8::StaticOrder S; S.init(SEQ, DM, G, bx);
            pg8::EpiRes E{HBc, HBn, SSn};
            pg8::gemm_phase<pg8::EpiRes, pg8::StaticOrder, true, PG8_SP2>(lds + RING_OFF, g, S, E, tid);
            if (BOTH(pb + 3)) GRID_BAR();
        }
        for (int pr_ = PROBE_REP_FF1; pr_ > 0; --pr_)
        if (!SKIP_FF1 && IN(pb + 4)) {
            PHASE_IDS;
            for (int ps_ = 0; ps_ < PROBE_REP_SMM; ++ps_) smm::ff1(HBn, (const bf16*)(ws + WS_WFF1) + (size_t)L * FF * DM, SSn, HID, lds, bx, G, tid);
            pg8::Gemm g{HBn, (const bf16*)(ws + WS_WFF1) + (size_t)L * FF * DM, SEQ, FF, DM}; pg8::StaticOrder S; S.init(SEQ, FF, G, bx);
            pg8::EpiFf1 E{SSn, HID};
            pg8::gemm_phase<pg8::EpiFf1, pg8::StaticOrder, PG8_ALIGN_FF1, PG8_SP2>(lds + RING_OFF, g, S, E, tid);
            if (BOTH(pb + 4)) GRID_BAR();
        }
        for (int pr_ = PROBE_REP_FF2; pr_ > 0; --pr_)
        if (!SKIP_FF2 && IN(pb + 5)) {
            PHASE_IDS;
            for (int ps_ = 0; ps_ < PROBE_REP_SMM; ++ps_) smm::residual16<FF2_ST>(HID, (const bf16*)(ws + WS_WFF2) + (size_t)L * DM * FF, FF, HBn, HBc, SSc, lds, bx, G, tid);
            pg8::Gemm g{HID, (const bf16*)(ws + WS_WFF2) + (size_t)L * DM * FF, SEQ, DM, FF}; pg8::StaticOrder S; S.init(SEQ, DM, G, bx);
            pg8::EpiRes E{HBn, HBc, SSc};
            pg8::gemm_phase<pg8::EpiRes, pg8::StaticOrder, true, PG8_SP2>(lds + RING_OFF, g, S, E, tid);
            if (BOTH(pb + 5)) GRID_BAR();
        }
        for (int pr_ = PROBE_REP_PLE; pr_ > 0; --pr_)
        if (!SKIP_PLE && IN(pb + 6)) {
            { PHASE_IDS;
              for (int ps_ = 0; ps_ < PROBE_REP_SMM; ++ps_) smm::ple16(HBc, (const bf16*)(ws + WS_WG) + (size_t)L * DM * DM, (const bf16*)(ws + WS_PB) + (size_t)L * MROWS * DPLE, (const bf16*)(ws + WS_WPP) + (size_t)L * DM * DPLE, SSc, HBn, SSn, (L == DEPTH - 1) ? Y + (size_t)SEQ * DM : nullptr, lds, bx, G, tid);
#if !PP_EARLY
              int kple = DPLE; asm volatile("" : "+s"(kple));
              pg8::Gemm g{(const bf16*)(ws + WS_PB) + (size_t)L * MROWS * DPLE, (const bf16*)(ws + WS_WPP) + (size_t)L * DM * DPLE, SEQ, DM, kple}; pg8::StaticOrder S; S.init(SEQ, DM, G, bx);
              pg8::EpiPP E{PP};
              pg8::gemm_phase<pg8::EpiPP, pg8::StaticOrder, true, PG8_SP2>(lds + RING_OFF, g, S, E, tid);
#endif
            }
            { PHASE_IDS; pg8::Gemm g{HBc, (const bf16*)(ws + WS_WG) + (size_t)L * DM * DM, SEQ, DM, DM}; pg8::StaticOrder S; S.init(SEQ, DM, G, bx);
              pg8::EpiGate E{SSc, PP, HBc, HBn, SSn, (L == DEPTH - 1) ? Y : nullptr};
              pg8::gemm_phase<pg8::EpiGate, pg8::StaticOrder, true, PG8_SP2>(lds + RING_OFF, g, S, E, tid); }
            if (BOTH(pb + 6)) GRID_BAR();
        }
    }
#undef IN
#undef BOTH
#undef GRID_BAR
}

extern "C" void kernel_launch(void* const* d_in, const int* in_sizes, int n_in, void* d_out, int out_size, void* d_ws, size_t ws_size, hipStream_t stream) {
    static int grid = 0;
    if (grid == 0) {
        if (n_in != 27 || (size_t)out_size != O_END || ws_size < WS_END) { fprintf(stderr, "kernel_launch: unexpected shapes (n_in %d out %d ws %zu); nothing launched\n", n_in, out_size, ws_size); grid = -1; return; }
        int dev = 0, cus = 0, per_cu = 0;
        if (hipGetDevice(&dev) != hipSuccess || hipDeviceGetAttribute(&cus, hipDeviceAttributeMultiprocessorCount, dev) != hipSuccess) { grid = -1; return; }
        if (hipFuncSetAttribute((const void*)fwd_kernel, hipFuncAttributeMaxDynamicSharedMemorySize, LDS_BYTES) != hipSuccess) { fprintf(stderr, "kernel_launch: hipFuncSetAttribute failed\n"); grid = -1; return; }
        if (hipOccupancyMaxActiveBlocksPerMultiprocessor(&per_cu, (const void*)fwd_kernel, NWAVES * 64, LDS_BYTES) != hipSuccess || per_cu < 1)
            fprintf(stderr, "kernel_launch: note: occupancy query reports %d workgroups per CU\n", per_cu);
        (void)hipGetLastError();
        grid = cus;
    }
    if (grid < 0) return;
    if (!N_LAUNCH_PER_PHASE) { if (hipMemsetAsync((char*)d_ws + WS_CTL, 0, CTL_ZERO_BYTES, stream) != hipSuccess) { fprintf(stderr, "kernel_launch: memset failed\n"); return; } }
    Args a{};
    for (int i = 0; i < 27; ++i) a.in[i] = (const float*)d_in[i];
    a.out = (float*)d_out; a.ws = (unsigned char*)d_ws;
    if (N_LAUNCH_PER_PHASE) {
        for (int ph = 0; ph < N_PHASES; ++ph) {
            if (ph >= 1 && ((ph - 1) % 7) == 1 && (((ph - 1) / 7) & 1) == 0) continue;
            a.ph_lo = ph; a.ph_hi = ph + 1;
            hipLaunchKernelGGL(fwd_kernel, dim3(grid), dim3(NWAVES * 64), LDS_BYTES, stream, a);
        }
    } else {
        a.ph_lo = 0; a.ph_hi = N_PHASES;
        hipLaunchKernelGGL(fwd_kernel, dim3(grid), dim3(NWAVES * 64), LDS_BYTES, stream, a);
    }
    const hipError_t le = hipPeekAtLastError();
    if (le != hipSuccess) fprintf(stderr, "kernel_launch: launch failed: %s\n", hipGetErrorName(le));
}
```

```cpp
#define STAGE_BOTH_MASK 4
#define SMP_RATIO 4
#define STICK_PRE 0
#define EVEN_PARITY 0
#define DEFER_SPLIT 0
#define EXP_UNROLL_ODD 8
#define EXP_UNROLL_EVEN 4
#include <hip/hip_runtime.h>
#include <cstdio>
#include <cstdint>

constexpr int DM = 1024, SEQ = 16384, NSMP = 256, MROWS = SEQ + NSMP, FF = 4096, DPLE = 256, HD = 64, NH = 16, PAST = 4096, BANDL = 512, DEPTH = 4;
constexpr int NPANEL = MROWS / 256;
constexpr float RMS_EPS = 1e-6f;
constexpr float LOG2E = 1.4426950408889634f;
constexpr float QSCALE = 0.125f * LOG2E;
constexpr size_t O_Y = 0;
constexpr size_t O_PAK = O_Y + (size_t)MROWS * DM;
constexpr size_t O_PAV = O_PAK + (size_t)2 * SEQ * 512;
constexpr size_t O_PBK = O_PAV + (size_t)2 * SEQ * 512;
constexpr size_t O_PBV = O_PBK + (size_t)2 * 512 * 512;
constexpr size_t O_PCK = O_PBV + (size_t)2 * 512 * 512;
constexpr size_t O_PCV = O_PCK + (size_t)2 * SEQ * 1024;
constexpr size_t O_PCF = O_PCV + (size_t)2 * SEQ * 1024;
constexpr size_t O_SAK = O_PCF + (size_t)2 * SEQ * 16;
constexpr size_t O_SAV = O_SAK + (size_t)2 * NSMP * 512;
constexpr size_t O_SBK = O_SAV + (size_t)2 * NSMP * 512;
constexpr size_t O_SBV = O_SBK + (size_t)2 * 16 * 512 * 512;
constexpr size_t O_SCK = O_SBV + (size_t)2 * 16 * 512 * 512;
constexpr size_t O_SCV = O_SCK + (size_t)2 * NSMP * 1024;
constexpr size_t O_SCF = O_SCV + (size_t)2 * NSMP * 1024;
constexpr size_t O_END = O_SCF + (size_t)2 * NSMP * 16;
static_assert(O_END == 137633792ull, "output size");
#ifndef PG8_WGM
#define PG8_WGM 8
#endif
namespace pg8 {
#define PG8_LAS __attribute__((address_space(3)))
typedef unsigned short bf16_t;
typedef short bf16x8 __attribute__((ext_vector_type(8)));
typedef float f32x4 __attribute__((ext_vector_type(4)));
typedef unsigned u32x4 __attribute__((ext_vector_type(4)));
constexpr int BM = 256, BK = 64, HALF = 128, HTB = HALF * BK * 2  , STAGE_BYTES = 8 * HTB, NXCD = 8, WGM = PG8_WGM;

__host__ __device__ __forceinline__ int lds_byte(int r, int c) { const int st = (r >> 4) * 2 + (c >> 5), rr = r & 15, cc = c & 31, ob = rr * 64 + cc * 2; return st * 1024 + (ob ^ (((ob >> 9) & 1) << 5)); }
__host__ __device__ __forceinline__ void stage_rc(int b, int& R, int& C) { const int st = b / 1024, sb = b % 1024, swz = sb ^ (((sb >> 9) & 1) << 5); R = (st >> 1) * 16 + swz / 64; C = (st & 1) * 32 + (swz % 64) / 2; }
__host__ __device__ __forceinline__ int perm32(int rho) { const int n = rho >> 4, i = rho & 15; return 8 * (i >> 2) + 4 * n + (i & 3); }

struct Unit { int pm, pn; };
struct Gemm { const bf16_t* A; const bf16_t* Bt; int M, N, K; };

struct StaticOrder {
    int nM, nN, nwg, G, c;
    __host__ __device__ void init(int M, int N, int G_, int c_) { nM = M / BM; nN = N / BM; nwg = nM * nN; G = G_; c = c_; }
    __host__ __device__ bool next(int i, Unit& u) const {
        const int L = i * G + c; if (L >= nwg) return false;
        int wgid = L; { const int q = nwg / NXCD, r = nwg % NXCD, xcd = wgid % NXCD, off = wgid / NXCD; wgid = (xcd < r ? xcd * (q + 1) : r * (q + 1) + (xcd - r) * q) + off; }
        const int nig = WGM * nN, gid = wgid / nig, fm = gid * WGM, gsz = (nM - fm) < WGM ? (nM - fm) : WGM;
        u.pm = fm + ((wgid % nig) % gsz); u.pn = (wgid % nig) / gsz; return true;
    }
    __device__ __forceinline__ void a_ready(const Unit&) const {}
    __device__ __forceinline__ void done(const Unit&) const {}
};
__device__ __forceinline__ unsigned cvt_pk_bf16(float lo, float hi) { unsigned r; asm volatile("v_cvt_pk_bf16_f32 %0, %1, %2" : "=v"(r) : "v"(lo), "v"(hi)); return r; }
typedef float f32x2 __attribute__((ext_vector_type(2)));
template <class Epi, class Sched, bool ALIGN_EPI = false, bool SP2 = false>
__device__ __forceinline__ void gemm_phase(PG8_LAS unsigned char* lds, const Gemm g, const Sched& S, const Epi& E, int tid_in) {
    int tid_ = tid_in; asm volatile("" : "+v"(tid_));
    const int tid = tid_, wid = __builtin_amdgcn_readfirstlane(tid >> 6), lane = tid & 63, wr = wid >> 2, wc = wid & 3, fr = lane & 15, fq = lane >> 4;
    const int K = g.K, nt = K / BK;
    unsigned voffA[2], voffB[2];
#pragma unroll
    for (int i = 0; i < 2; ++i) { int R, C; stage_rc(tid * 16 + i * 8192, R, C); const int Rb = Epi::PERM ? ((R & ~31) + perm32(R & 31)) : R;
        voffA[i] = (unsigned)(R * K + C) * 2u; voffB[i] = (unsigned)(Rb * K + C) * 2u; }
    const size_t kstep = (size_t)(BK * 2);
    const size_t hstep = (size_t)HALF * K * 2;
    const size_t tstep = 2 * hstep;
    const unsigned ldsw = (unsigned)wid * 1024u;
    const int aoff = lds_byte(wr * 64 + fr, fq * 8), boff = lds_byte(wc * 32 + fr, fq * 8);
#define PG8_SA(b, h) (((b) * 2 + (h)) * HTB)
#define PG8_SB(b, h) ((4 + (b) * 2 + (h)) * HTB)
#ifndef PG8_AUX_A
#define PG8_AUX_A 0
#endif
#ifndef PG8_AUX_B
#define PG8_AUX_B 0
#endif
#define PG8_AUX_voffA PG8_AUX_A
#define PG8_AUX_voffB PG8_AUX_B
#define PG8_STAGE(bufoff, gbase, voff) do { _Pragma("unroll") for (int _i = 0; _i < 2; ++_i) \
        __builtin_amdgcn_global_load_lds((const unsigned*)((const char*)(gbase) + (voff)[_i]), (PG8_LAS unsigned*)(lds + (bufoff) + ldsw + _i * 8192), 16, 0, PG8_AUX_##voff); } while (0)
#define PG8_LDA(dst, b, h) do { _Pragma("unroll") for (int m = 0; m < 4; ++m) _Pragma("unroll") for (int k = 0; k < 2; ++k) dst[m][k] = *(const PG8_LAS bf16x8*)(lds + PG8_SA(b, h) + aoff + m * 2048 + k * 1024); } while (0)
#define PG8_LDB(dst, b, h) do { _Pragma("unroll") for (int n = 0; n < 2; ++n) _Pragma("unroll") for (int k = 0; k < 2; ++k) dst[n][k] = *(const PG8_LAS bf16x8*)(lds + PG8_SB(b, h) + boff + n * 2048 + k * 1024); } while (0)
#define PG8_MMA(ai, bj, At, Bt) do { __builtin_amdgcn_s_setprio(1); _Pragma("unroll") for (int m = 0; m < 4; ++m) _Pragma("unroll") for (int n = 0; n < 2; ++n) _Pragma("unroll") for (int k = 0; k < 2; ++k) \
        acc[ai][bj][m][n] = __builtin_amdgcn_mfma_f32_16x16x32_bf16(Bt[n][k], At[m][k], acc[ai][bj][m][n], 0, 0, 0); __builtin_amdgcn_s_setprio(0); } while (0)
#define PG8_WAIT_V(n) asm volatile("s_waitcnt vmcnt(" #n ")" ::: "memory")
#define PG8_WAIT_L(n) asm volatile("s_waitcnt lgkmcnt(" #n ")" ::: "memory")
#define PG8_BAR __builtin_amdgcn_s_barrier()
#define PG8_SCHED __builtin_amdgcn_sched_barrier(0)
    Unit cur, nxt; int ui = 0;
    if (!S.next(0, cur)) return;
    f32x4 acc[2][2][4][2];
#pragma unroll
    for (int a = 0; a < 2; ++a)
#pragma unroll
        for (int b = 0; b < 2; ++b)
#pragma unroll
            for (int m = 0; m < 4; ++m)
#pragma unroll
                for (int n = 0; n < 2; ++n) acc[a][b][m][n] = (f32x4){0.f, 0.f, 0.f, 0.f};
    bf16x8 At[4][2], B0[2][2], B1[2][2];
    const char* cA = (const char*)g.A + (size_t)cur.pm * tstep; const char* cB = (const char*)g.Bt + (size_t)cur.pn * tstep;
    S.a_ready(cur);
    if constexpr (SP2) {
        PG8_STAGE(PG8_SB(0, 0), cB, voffB); PG8_STAGE(PG8_SB(0, 1), cB + hstep, voffB); PG8_STAGE(PG8_SA(0, 0), cA, voffA); PG8_STAGE(PG8_SA(0, 1), cA + hstep, voffA);
        if (wr == 1) PG8_BAR;
        PG8_WAIT_V(2); PG8_BAR;
        PG8_STAGE(PG8_SB(1, 0), cB + kstep, voffB); PG8_STAGE(PG8_SA(1, 0), cA + kstep, voffA); PG8_STAGE(PG8_SB(1, 1), cB + hstep + kstep, voffB);
        PG8_WAIT_V(6); PG8_BAR;
    } else {
        PG8_STAGE(PG8_SB(0, 0), cB, voffB); PG8_STAGE(PG8_SA(0, 0), cA, voffA); PG8_STAGE(PG8_SB(0, 1), cB + hstep, voffB); PG8_STAGE(PG8_SA(0, 1), cA + hstep, voffA);
        if (wr == 1) PG8_BAR;
        PG8_WAIT_V(4); PG8_BAR;
        PG8_STAGE(PG8_SB(1, 0), cB + kstep, voffB); PG8_STAGE(PG8_SA(1, 0), cA + kstep, voffA); PG8_STAGE(PG8_SB(1, 1), cB + hstep + kstep, voffB);
        PG8_WAIT_V(6); PG8_BAR;
    }
    for (;;) {
        const bool has_next = S.next(ui + 1, nxt);
        const char* nA = has_next ? (const char*)g.A + (size_t)nxt.pm * tstep : cA; const char* nB = has_next ? (const char*)g.Bt + (size_t)nxt.pn * tstep : cB;
        for (int t = 0; t < nt; t += 2) {
            const bool last = (t == nt - 2);
            const char* a1 = cA + (size_t)(t + 1) * kstep;
            const char* a2 = last ? nA : cA + (size_t)(t + 2) * kstep; const char* b2 = last ? nB : cB + (size_t)(t + 2) * kstep;
            const char* a3 = a2 + kstep; const char* b3 = b2 + kstep;
            if (last && has_next) S.a_ready(nxt);
            if constexpr (SP2) {
            PG8_LDB(B0, 0, 0); PG8_LDB(B1, 0, 1); PG8_SCHED; PG8_LDA(At, 0, 0); PG8_STAGE(PG8_SA(1, 1), a1 + hstep, voffA);
            PG8_WAIT_V(8); PG8_WAIT_L(0); PG8_BAR; PG8_MMA(0, 0, At, B0); PG8_MMA(0, 1, At, B1); PG8_BAR; PG8_SCHED;
            PG8_LDA(At, 0, 1); PG8_STAGE(PG8_SB(0, 0), b2, voffB); PG8_STAGE(PG8_SB(0, 1), b2 + hstep, voffB); PG8_STAGE(PG8_SA(0, 0), a2, voffA);
            PG8_WAIT_V(8); PG8_WAIT_L(0); PG8_BAR; PG8_MMA(1, 0, At, B0); PG8_MMA(1, 1, At, B1); PG8_BAR; PG8_SCHED;
            PG8_LDB(B0, 1, 0); PG8_LDB(B1, 1, 1); PG8_SCHED; PG8_LDA(At, 1, 0); PG8_STAGE(PG8_SA(0, 1), a2 + hstep, voffA);
            PG8_WAIT_V(8); PG8_WAIT_L(0); PG8_BAR; PG8_MMA(0, 0, At, B0); PG8_MMA(0, 1, At, B1); PG8_BAR; PG8_SCHED;
            PG8_LDA(At, 1, 1); PG8_STAGE(PG8_SB(1, 0), b3, voffB); PG8_STAGE(PG8_SB(1, 1), b3 + hstep, voffB); PG8_STAGE(PG8_SA(1, 0), a3, voffA);
            PG8_WAIT_V(8); PG8_WAIT_L(0); PG8_BAR; PG8_MMA(1, 0, At, B0); PG8_MMA(1, 1, At, B1); PG8_BAR; PG8_SCHED;
            } else {
            PG8_LDB(B0, 0, 0); PG8_SCHED; PG8_LDA(At, 0, 0); PG8_STAGE(PG8_SA(1, 1), a1 + hstep, voffA);
            PG8_WAIT_L(8); PG8_BAR; PG8_WAIT_L(0); PG8_MMA(0, 0, At, B0); PG8_BAR; PG8_SCHED;
            PG8_LDB(B1, 0, 1); PG8_STAGE(PG8_SB(0, 0), b2, voffB);
            PG8_BAR; PG8_WAIT_L(0); PG8_MMA(0, 1, At, B1); PG8_BAR;
            PG8_LDA(At, 0, 1); PG8_STAGE(PG8_SA(0, 0), a2, voffA);
            PG8_BAR; PG8_WAIT_L(0); PG8_MMA(1, 0, At, B0); PG8_BAR; PG8_SCHED;
            PG8_STAGE(PG8_SB(0, 1), b2 + hstep, voffB);
            PG8_WAIT_V(6); PG8_BAR; PG8_MMA(1, 1, At, B1); PG8_BAR;
            PG8_LDB(B0, 1, 0); PG8_SCHED; PG8_LDA(At, 1, 0); PG8_STAGE(PG8_SA(0, 1), a2 + hstep, voffA);
            PG8_WAIT_L(8); PG8_BAR; PG8_WAIT_L(0); PG8_MMA(0, 0, At, B0); PG8_BAR; PG8_SCHED;
            PG8_LDB(B1, 1, 1); PG8_STAGE(PG8_SB(1, 0), b3, voffB);
            PG8_BAR; PG8_WAIT_L(0); PG8_MMA(0, 1, At, B1); PG8_BAR;
            PG8_LDA(At, 1, 1); PG8_STAGE(PG8_SA(1, 0), a3, voffA);
            PG8_BAR; PG8_WAIT_L(0); PG8_MMA(1, 0, At, B0); PG8_BAR; PG8_SCHED;
            PG8_STAGE(PG8_SB(1, 1), b3 + hstep, voffB);
            PG8_WAIT_V(6); PG8_BAR; PG8_MMA(1, 1, At, B1); PG8_BAR;
            }
        }
        if constexpr (ALIGN_EPI) { if (wr == 0) PG8_BAR; }
        if constexpr (!Epi::AFTER_DRAIN) { E(acc, cur, wr, wc, fr, fq); S.done(cur); }
        if (!has_next) break;
#pragma unroll
        for (int a = 0; a < 2; ++a)
#pragma unroll
            for (int b = 0; b < 2; ++b)
#pragma unroll
                for (int m = 0; m < 4; ++m)
#pragma unroll
                    for (int n = 0; n < 2; ++n) acc[a][b][m][n] = (f32x4){0.f, 0.f, 0.f, 0.f};
        cur = nxt; cA = nA; cB = nB; ++ui;
        if constexpr (ALIGN_EPI) { if (wr == 1) PG8_BAR; }
    }
    PG8_WAIT_V(0);
    if constexpr (!ALIGN_EPI) { if (wr == 0) PG8_BAR; }
    PG8_BAR;
    if constexpr (Epi::AFTER_DRAIN) { E.fused(acc, cur, wr, wc, fr, fq, lds, wid, lane); S.done(cur); }
#undef PG8_SA
#undef PG8_SB
#undef PG8_STAGE
#undef PG8_LDA
#undef PG8_LDB
#undef PG8_MMA
#undef PG8_WAIT_V
#undef PG8_WAIT_L
#undef PG8_BAR
#undef PG8_SCHED
}
}

namespace pg8 {
typedef unsigned u32x2 __attribute__((ext_vector_type(2)));
__device__ __forceinline__ float rsq_f(float x) { return __builtin_amdgcn_rsqf(x); }
__device__ __forceinline__ float row_rscale(const float* ssq, int row) {
    const f32x4* p = (const f32x4*)(ssq + (size_t)row * 16);
    const f32x4 a = p[0], b = p[1], c = p[2], d = p[3];
    const f32x4 s = (a + b) + (c + d);
    return rsq_f(((s[0] + s[1]) + (s[2] + s[3])) * (1.0f / 1024.0f) + RMS_EPS);
}
__device__ __forceinline__ void row_rscale8(const float* ssq, int row0, int fq, float (&r)[2][4]) {
    f32x4 p[2][4];
#pragma unroll
    for (int ai = 0; ai < 2; ++ai)
#pragma unroll
        for (int m = 0; m < 4; ++m) p[ai][m] = *(const f32x4*)(ssq + (size_t)(row0 + ai * HALF + m * 16) * 16 + 4 * fq);
#pragma unroll
    for (int ai = 0; ai < 2; ++ai)
#pragma unroll
        for (int m = 0; m < 4; ++m) { float s = (p[ai][m][0] + p[ai][m][1]) + (p[ai][m][2] + p[ai][m][3]); s += __shfl_xor(s, 16); s += __shfl_xor(s, 32); r[ai][m] = rsq_f(s * (1.0f / 1024.0f) + RMS_EPS); }
}
__device__ __forceinline__ float log_sigmoid_f(float x) { return fminf(x, 0.f) - 0.6931471805599453f * __builtin_amdgcn_logf(1.0f + __builtin_amdgcn_exp2f(-1.4426950408889634f * fabsf(x))); }
__device__ __forceinline__ float sumsq4(const f32x4 v) { return (v[0] * v[0] + v[1] * v[1]) + (v[2] * v[2] + v[3] * v[3]); }
__device__ __forceinline__ u32x4 pack8(const f32x4 a, const f32x4 b) { u32x4 w; w.x = cvt_pk_bf16(a[0], a[1]); w.y = cvt_pk_bf16(a[2], a[3]); w.z = cvt_pk_bf16(b[0], b[1]); w.w = cvt_pk_bf16(b[2], b[3]); return w; }

__device__ __forceinline__ float* kv_dst(float* out, int odd, int j, int t  , int hd, int row) {
    const bool smp = row >= SEQ; const int rs = row - SEQ;
    if (odd) {
        const size_t base = smp ? (t == 1 ? O_SCK : O_SCV) : (t == 1 ? O_PCK : O_PCV);
        const size_t r = smp ? (size_t)(j * NSMP + rs) : (size_t)j * SEQ + row;
        return out + base + (r * 16 + hd) * 64;
    }
    if (hd < 8) {
        const size_t base = smp ? (t == 1 ? O_SAK : O_SAV) : (t == 1 ? O_PAK : O_PAV);
        const size_t r = smp ? (size_t)(j * NSMP + rs) : (size_t)j * SEQ + row;
        return out + base + (r * 8 + hd) * 64;
    }
    if (smp) { const int b = rs >> 4, tt = rs & 15; return out + (t == 1 ? O_SBK : O_SBV) + ((size_t)((j * 16 + b) * 512 + 496 + tt) * 8 + (hd - 8)) * 64; }
    if (row < SEQ - 512) return nullptr;
    return out + (t == 1 ? O_PBK : O_PBV) + ((size_t)(j * 512 + row - (SEQ - 512)) * 8 + (hd - 8)) * 64;
}

struct EpiIn {
    static constexpr bool PERM = true, AFTER_DRAIN = false;
    const float* ssq; bf16_t* Qb; float* out; const float *gq; long long gk_minus_gq; int odd, j;
    __device__ __forceinline__ void operator()(const f32x4 (&acc)[2][2][4][2], const Unit& u, int wr, int wc, int fr_in, int fq_in) const {
        int fr = fr_in, fq = fq_in; asm volatile("" : "+v"(fr), "+v"(fq));
        const int row0 = u.pm * BM + wr * 64 + fr;
        float rr[2][4]; row_rscale8(ssq, row0, fq, rr);
        const int t = u.pn >> 2, hd = (u.pn & 3) * 4 + wc;
        const bool norm = (t < 2) && (odd || hd >= 8);
        const float* g = (const float*)((const char*)gq + (t == 1 ? gk_minus_gq : 0ll));
        f32x4 gv[2][2];
#pragma unroll
        for (int bj = 0; bj < 2; ++bj)
#pragma unroll
            for (int n = 0; n < 2; ++n) gv[bj][n] = norm ? *(const f32x4*)(g + 32 * bj + 8 * fq + 4 * n) : (f32x4){1.f, 1.f, 1.f, 1.f};
        bf16_t* ob = Qb + (size_t)t * ((size_t)MROWS * DM);
        const int colh = hd * 64 + 8 * fq;
#pragma unroll
        for (int ai = 0; ai < 2; ++ai)
#pragma unroll
            for (int m = 0; m < 4; ++m) {
                const int row = row0 + ai * HALF + m * 16; const float r = rr[ai][m];
                f32x4 v[2][2]; float s = 0.f;
#pragma unroll
                for (int bj = 0; bj < 2; ++bj)
#pragma unroll
                    for (int n = 0; n < 2; ++n) { v[bj][n] = acc[ai][bj][m][n] * r; s += sumsq4(v[bj][n]); }
                if (norm) {
                    s += __shfl_xor(s, 16); s += __shfl_xor(s, 32);
                    const float rs = rsq_f(s * (1.0f / 64.0f) + RMS_EPS);
#pragma unroll
                    for (int bj = 0; bj < 2; ++bj)
#pragma unroll
                        for (int n = 0; n < 2; ++n) v[bj][n] = v[bj][n] * rs * gv[bj][n];
                }
                bf16_t* orow = ob + (size_t)row * DM + colh;
                if (t == 0) {
#pragma unroll
                    for (int bj = 0; bj < 2; ++bj) *(u32x4*)(orow + 32 * bj) = pack8(v[bj][0] * QSCALE, v[bj][1] * QSCALE);
                } else {
#pragma unroll
                    for (int bj = 0; bj < 2; ++bj) *(u32x4*)(orow + 32 * bj) = pack8(v[bj][0], v[bj][1]);
                }
                if (m == 3) asm volatile("" ::: "memory");
            }
    }
};

__device__ __forceinline__ float bf_lo(unsigned w) { return __uint_as_float(w << 16); }
__device__ __forceinline__ float bf_hi(unsigned w) { return __uint_as_float(w & 0xffff0000u); }
__device__ __forceinline__ void unpack8(const u32x4 w, f32x4& a, f32x4& b) { a = (f32x4){bf_lo(w.x), bf_hi(w.x), bf_lo(w.y), bf_hi(w.y)}; b = (f32x4){bf_lo(w.z), bf_hi(w.z), bf_lo(w.w), bf_hi(w.w)}; }
struct EpiRes {
    static constexpr bool PERM = true, AFTER_DRAIN = false;
    const bf16_t* hb_in; bf16_t* hb_out; float* ssq;
    __device__ __forceinline__ void operator()(const f32x4 (&acc)[2][2][4][2], const Unit& u, int wr, int wc, int fr_in, int fq_in) const {
        int fr = fr_in, fq = fq_in; asm volatile("" : "+v"(fr), "+v"(fq));
        const int row0 = u.pm * BM + wr * 64 + fr, col0 = u.pn * BM + wc * 32 + 8 * fq;
#pragma unroll
        for (int ai = 0; ai < 2; ++ai)
#pragma unroll
            for (int m = 0; m < 4; ++m) {
                const int row = row0 + ai * HALF + m * 16;
                float s = 0.f;
#pragma unroll
                for (int bj = 0; bj < 2; ++bj) {
                    const size_t off = (size_t)row * DM + col0 + bj * HALF;
                    f32x4 h0, h1; unpack8(*(const u32x4*)(hb_in + off), h0, h1);
                    const f32x4 o0 = acc[ai][bj][m][0] + h0, o1 = acc[ai][bj][m][1] + h1;
                    *(u32x4*)(hb_out + off) = pack8(o0, o1);
                    s += sumsq4(o0) + sumsq4(o1);
                }
                s += __shfl_xor(s, 16); s += __shfl_xor(s, 32);
                if (fq == 0) ssq[(size_t)row * 16 + u.pn * 4 + wc] = s;
                if (m == 3) asm volatile("" ::: "memory");
            }
    }
};

struct EpiFf1 {
    static constexpr bool PERM = true, AFTER_DRAIN = false;
    const float* ssq; bf16_t* hid;
    __device__ __forceinline__ void operator()(const f32x4 (&acc)[2][2][4][2], const Unit& u, int wr, int wc, int fr_in, int fq_in) const {
        int fr = fr_in, fq = fq_in; asm volatile("" : "+v"(fr), "+v"(fq));
        const int row0 = u.pm * BM + wr * 64 + fr, col0 = u.pn * BM + wc * 32 + 8 * fq;
        float rr[2][4]; row_rscale8(ssq, row0, fq, rr);
#pragma unroll
        for (int ai = 0; ai < 2; ++ai)
#pragma unroll
            for (int m = 0; m < 4; ++m) {
                const int row = row0 + ai * HALF + m * 16; const float r = rr[ai][m];
#pragma unroll
                for (int bj = 0; bj < 2; ++bj) {
                    f32x4 a = acc[ai][bj][m][0] * r, b = acc[ai][bj][m][1] * r;
#pragma unroll
                    for (int i = 0; i < 4; ++i) { const float x = fmaxf(a[i], 0.f), y = fmaxf(b[i], 0.f); a[i] = x * x; b[i] = y * y; }
                    *(u32x4*)(hid + (size_t)row * FF + col0 + bj * HALF) = pack8(a, b);
                }
                if (m == 3) asm volatile("" ::: "memory");
            }
    }
};

struct EpiPP {
    static constexpr bool PERM = true, AFTER_DRAIN = false;
    bf16_t* pp;
    __device__ __forceinline__ void operator()(const f32x4 (&acc)[2][2][4][2], const Unit& u, int wr, int wc, int fr_in, int fq_in) const {
        int fr = fr_in, fq = fq_in; asm volatile("" : "+v"(fr), "+v"(fq));
        const int row0 = u.pm * BM + wr * 64 + fr, col0 = u.pn * BM + wc * 32 + 8 * fq;
#pragma unroll
        for (int ai = 0; ai < 2; ++ai)
#pragma unroll
            for (int m = 0; m < 4; ++m) {
                const int row = row0 + ai * HALF + m * 16;
#pragma unroll
                for (int bj = 0; bj < 2; ++bj) *(u32x4*)(pp + (size_t)row * DM + col0 + bj * HALF) = pack8(acc[ai][bj][m][0], acc[ai][bj][m][1]);
                if (m == 3) asm volatile("" ::: "memory");
            }
    }
};

struct EpiGate {
    static constexpr bool PERM = true, AFTER_DRAIN = false;
    const float* ssq_in; const bf16_t* pp; const bf16_t* hb_in; bf16_t* hb_out; float* ssq_out; float* yout;
    __device__ __forceinline__ void operator()(const f32x4 (&acc)[2][2][4][2], const Unit& u, int wr, int wc, int fr_in, int fq_in) const {
        int fr = fr_in, fq = fq_in; asm volatile("" : "+v"(fr), "+v"(fq));
        const int row0 = u.pm * BM + wr * 64 + fr, col0 = u.pn * BM + wc * 32 + 8 * fq;
        float rr[2][4]; row_rscale8(ssq_in, row0, fq, rr);
#pragma unroll
        for (int ai = 0; ai < 2; ++ai)
#pragma unroll
            for (int m = 0; m < 4; ++m) {
                const int row = row0 + ai * HALF + m * 16; const float r = rr[ai][m];
                float s = 0.f;
#pragma unroll
                for (int bj = 0; bj < 2; ++bj) {
                    const size_t off = (size_t)row * DM + col0 + bj * HALF;
                    f32x4 p0, p1, o0, o1; unpack8(*(const u32x4*)(pp + off), p0, p1); unpack8(*(const u32x4*)(hb_in + off), o0, o1);
                    const f32x4 a = acc[ai][bj][m][0] * (-r * LOG2E), b = acc[ai][bj][m][1] * (-r * LOG2E);
#pragma unroll
                    for (int i = 0; i < 4; ++i) {
                        o0[i] += __builtin_amdgcn_rcpf(1.0f + __builtin_amdgcn_exp2f(a[i])) * p0[i];
                        o1[i] += __builtin_amdgcn_rcpf(1.0f + __builtin_amdgcn_exp2f(b[i])) * p1[i];
                    }
                    if (yout) { __builtin_nontemporal_store(o0, (f32x4*)(yout + off)); __builtin_nontemporal_store(o1, (f32x4*)(yout + off + 4)); }
                    *(u32x4*)(hb_out + off) = pack8(o0, o1);
                    s += sumsq4(o0) + sumsq4(o1);
                }
                s += __shfl_xor(s, 16); s += __shfl_xor(s, 32);
                if (fq == 0) ssq_out[(size_t)row * 16 + u.pn * 4 + wc] = s;
                if (m == 3) asm volatile("" ::: "memory");
            }
    }
};
}

namespace att {
#define ALDS __attribute__((address_space(3)))
typedef ALDS unsigned char* lptr;
typedef unsigned short bf16;
typedef short bf16x8 __attribute__((ext_vector_type(8)));
typedef short s16x4 __attribute__((ext_vector_type(4)));
typedef float f32x16 __attribute__((ext_vector_type(16)));
typedef float f32x4 __attribute__((ext_vector_type(4)));
typedef unsigned u32x4 __attribute__((ext_vector_type(4)));
typedef unsigned u32x2 __attribute__((ext_vector_type(2)));
constexpr float NEG_INF = -INFINITY;

__device__ __forceinline__ int crow(int r, int hi) { return (r & 3) + 8 * (r >> 2) + 4 * hi; }
__device__ __forceinline__ unsigned cvtpk(float lo, float hi) { unsigned r; asm volatile("v_cvt_pk_bf16_f32 %0, %1, %2" : "=v"(r) : "v"(lo), "v"(hi)); return r; }
__device__ __forceinline__ float ex2(float x) { return __builtin_amdgcn_exp2f(x); }
__device__ __forceinline__ float lg2(float x) { return __builtin_amdgcn_logf(x); }
__device__ __forceinline__ void pair_vals(float x, float& lo, float& hi) {
    auto rr = __builtin_amdgcn_permlane32_swap(__float_as_uint(x), __float_as_uint(x), false, false);
    lo = __uint_as_float(rr[0]); hi = __uint_as_float(rr[1]);
}

__device__ __forceinline__ void qkt(f32x16& p0, f32x16& p1, lptr Ks, const bf16x8 (&qr)[4], int r32, int hi) {
    const lptr kb = Ks + hi * 1024 + r32 * 16;
    f32x16 a = {}, b = {};
#pragma unroll
    for (int d0 = 0; d0 < 4; ++d0) {
        const bf16x8 b0 = *(const ALDS bf16x8*)(kb + d0 * 2048), b1 = *(const ALDS bf16x8*)(kb + d0 * 2048 + 512);
        a = __builtin_amdgcn_mfma_f32_32x32x16_bf16(b0, qr[d0], a, 0, 0, 0);
        b = __builtin_amdgcn_mfma_f32_32x32x16_bf16(b1, qr[d0], b, 0, 0, 0);
    }
    p0 = a; p1 = b;
}
__device__ __forceinline__ void pv(f32x16 (&o)[2], int vb, const f32x16& p0, const f32x16& p1) {
    u32x4 pw[4];
#pragma unroll
    for (int k = 0; k < 2; ++k) {
        pw[k]     = (u32x4){cvtpk(p0[8 * k], p0[8 * k + 1]), cvtpk(p0[8 * k + 2], p0[8 * k + 3]), cvtpk(p0[8 * k + 4], p0[8 * k + 5]), cvtpk(p0[8 * k + 6], p0[8 * k + 7])};
        pw[2 + k] = (u32x4){cvtpk(p1[8 * k], p1[8 * k + 1]), cvtpk(p1[8 * k + 2], p1[8 * k + 3]), cvtpk(p1[8 * k + 4], p1[8 * k + 5]), cvtpk(p1[8 * k + 6], p1[8 * k + 7])};
    }
#pragma unroll
    for (int d0 = 0; d0 < 2; ++d0) {
        s16x4 lo[4], hi[4];
#pragma unroll
        for (int ks = 0; ks < 4; ++ks) {
            asm volatile("ds_read_b64_tr_b16 %0,%1 offset:%c2" : "=&v"(lo[ks]) : "v"(vb), "i"(d0 * 4096 + ks * 1024) : "memory");
            asm volatile("ds_read_b64_tr_b16 %0,%1 offset:%c2" : "=&v"(hi[ks]) : "v"(vb), "i"(d0 * 4096 + ks * 1024 + 512) : "memory");
        }
        asm volatile("s_waitcnt lgkmcnt(0)" ::: "memory"); __builtin_amdgcn_sched_barrier(0);
#pragma unroll
        for (int ks = 0; ks < 4; ++ks) {
            const bf16x8 vf = (bf16x8){lo[ks][0], lo[ks][1], lo[ks][2], lo[ks][3], hi[ks][0], hi[ks][1], hi[ks][2], hi[ks][3]};
            o[d0] = __builtin_amdgcn_mfma_f32_32x32x16_bf16(__builtin_bit_cast(bf16x8, pw[ks]), vf, o[d0], 0, 0, 0);
        }
    }
}
__device__ __forceinline__ int pv_base(lptr Vs, int lane, int hi) { return (int)(unsigned)(uintptr_t)Vs + ((lane >> 4) & 1) * 32 + (lane & 3) * 8 + (4 * hi + ((lane & 15) >> 2)) * 64; }

constexpr float RESC_THR = 8.0f;
__device__ __forceinline__ void softmax_tile(f32x16& p0, f32x16& p1, float& m, float& l, f32x16 (&o)[2], ALDS float* wsf, int r32, int hi) {
    float a = fmaxf(p0[0], p1[0]);
#pragma unroll
    for (int r = 1; r < 16; ++r) a = fmaxf(a, fmaxf(p0[r], p1[r]));
    float lo, hv; pair_vals(a, lo, hv);
    const float rm = fmaxf(lo, hv);
    if (__any(rm > m + RESC_THR)) {
        const float mn = fmaxf(m, rm);
        const float f = (mn == NEG_INF) ? 1.0f : ex2(m - mn);
        l *= f; m = mn;
        if (hi == 0) wsf[r32] = f;
        asm volatile("s_waitcnt lgkmcnt(0)" ::: "memory");
#pragma unroll
        for (int q4 = 0; q4 < 4; ++q4) {
            const f32x4 fv = *(const ALDS f32x4*)(wsf + 8 * q4 + 4 * hi);
#pragma unroll
            for (int i = 0; i < 4; ++i) { o[0][4 * q4 + i] *= fv[i]; o[1][4 * q4 + i] *= fv[i]; }
        }
        asm volatile("s_waitcnt lgkmcnt(0)" ::: "memory");
    }
    const float ms = (m == NEG_INF) ? 0.f : m;
    float s = 0.f;
#pragma unroll
    for (int r = 0; r < 16; ++r) { p0[r] = ex2(p0[r] - ms); p1[r] = ex2(p1[r] - ms); s += p0[r] + p1[r]; }
    l += s;
}

constexpr float STICK_REM_MIN = 1e-37f;
__device__ __forceinline__ void stick_tile(f32x16& p0, f32x16& p1, float& rem, int kpos0, int qpos, bool need_mask, int nvalid, int hi) {
    float be[32], qk[32];
#pragma unroll
    for (int r = 0; r < 16; ++r) {
#pragma unroll
        for (int hh = 0; hh < 2; ++hh) {
            const float z = fminf(fmaxf(hh ? p1[r] : p0[r], -100.f), 100.f);
            const float e = ex2(-z);
            float b = __builtin_amdgcn_rcpf(1.0f + e), q = e * b;
            if (need_mask) { const int kk = crow(r, hi) + 32 * hh; const bool vis = (kk < nvalid) && (kpos0 + kk < qpos); b = vis ? b : 0.f; q = vis ? q : 1.0f; }
            be[r + 16 * hh] = b; qk[r + 16 * hh] = q;
        }
    }
    float ev[8], od[8];
#pragma unroll
    for (int j = 0; j < 8; ++j) { const float bp = (qk[4 * j] * qk[4 * j + 1]) * (qk[4 * j + 2] * qk[4 * j + 3]); pair_vals(bp, ev[j], od[j]); }
    float S = rem, mine[8];
#pragma unroll
    for (int j = 7; j >= 0; --j) { const float so = S; S *= od[j]; const float se = S; S *= ev[j]; mine[j] = hi ? so : se; }
#pragma unroll
    for (int j = 0; j < 8; ++j) {
        const float a3 = mine[j], a2 = a3 * qk[4 * j + 3], a1 = a2 * qk[4 * j + 2], a0 = a1 * qk[4 * j + 1];
        const float w0 = be[4 * j] * a0, w1 = be[4 * j + 1] * a1, w2 = be[4 * j + 2] * a2, w3 = be[4 * j + 3] * a3;
        if (j < 4) { p0[4 * j] = w0; p0[4 * j + 1] = w1; p0[4 * j + 2] = w2; p0[4 * j + 3] = w3; }
        else { p1[4 * j - 16] = w0; p1[4 * j - 15] = w1; p1[4 * j - 14] = w2; p1[4 * j - 13] = w3; }
    }
    rem = S;
}

__device__ __forceinline__ void store_o(const f32x16 (&o)[2], float inv  , ALDS float* wsf, ALDS bf16* stg, bf16* Orow0  , int nrows, int lane, int r32, int hi) {
    if (hi == 0) wsf[r32] = inv;
    asm volatile("s_waitcnt lgkmcnt(0)" ::: "memory");
    float rli[16];
#pragma unroll
    for (int q4 = 0; q4 < 4; ++q4) { const f32x4 fv = *(const ALDS f32x4*)(wsf + 8 * q4 + 4 * hi);
#pragma unroll
        for (int i = 0; i < 4; ++i) rli[4 * q4 + i] = fv[i]; }
#pragma unroll
    for (int r = 0; r < 16; ++r) { const int orow = crow(r, hi);
#pragma unroll
        for (int d0 = 0; d0 < 2; ++d0) stg[orow * 64 + d0 * 32 + r32] = (bf16)(cvtpk(o[d0][r] * rli[r], 0.f) & 0xffffu); }
    asm volatile("s_waitcnt lgkmcnt(0)" ::: "memory");
#pragma unroll
    for (int i = 0; i < 4; ++i) { const int row = i * 8 + (lane >> 3), ch = lane & 7; const u32x4 v = *(const ALDS u32x4*)(stg + row * 64 + ch * 8);
        if (row < nrows) *(u32x4*)(Orow0 + (size_t)row * DM + ch * 8) = v; }
    asm volatile("s_waitcnt lgkmcnt(0)" ::: "memory");
}

constexpr int SLOT_K = 0, SLOT_V = 8192, SLOT_B = 16384, SLOT_BYTES = 17408;
constexpr int L_WSF = 3 * SLOT_BYTES, L_OST = L_WSF + 2048, L_TAB = L_OST + 8 * 4096, L_PROMPT_END = L_TAB + 1280;
constexpr int SW_BYTES = 8192 + 8192 + 256 + 256, SW_K = 0, SW_V = 8192, SW_BIAS = 16384, SW_WSF = 16640;
constexpr int ATT_LDS_BYTES = 8 * SW_BYTES;
static_assert(L_PROMPT_END <= ATT_LDS_BYTES, "attention LDS map");

__device__ __forceinline__ void qkt_bias(f32x16& p0, f32x16& p1, lptr Bs, int r32, int hi) {
    const s16x4 k0 = *(const ALDS s16x4*)(Bs + r32 * 16 + hi * 8), k1 = *(const ALDS s16x4*)(Bs + (r32 + 32) * 16 + hi * 8);
    const short one = hi ? (short)0 : (short)0x3F80;
    const s16x4 ones = (s16x4){one, one, one, (short)0};
    p0 = __builtin_amdgcn_mfma_f32_32x32x8bf16_1k(k0, ones, p0, 0, 0, 0);
    p1 = __builtin_amdgcn_mfma_f32_32x32x8bf16_1k(k1, ones, p1, 0, 0, 0);
}
__device__ __forceinline__ float bf_round(float x) { return __uint_as_float(cvtpk(x, 0.f) << 16); }

template <int MODE>
__device__ __forceinline__ void process_tile(f32x16& p0, f32x16& p1, int t, int qb, int w, int qpos, int wq_lo, lptr slot, const ALDS float* rel, float& m, float& l, float& cum, f32x16 (&o)[2],
                                             ALDS float* wsf, int lane, int r32, int hi) {
    if (MODE == 0) stick_tile(p0, p1, cum, 64 * t, qpos, 64 * t + 63 >= wq_lo, 64, hi);
    else {
        if (MODE == 2) {
            if (64 * t + 63 > wq_lo) {
#pragma unroll
                for (int r = 0; r < 16; ++r) { const int kp = 64 * t + crow(r, hi); if (kp > qpos) p0[r] = NEG_INF; if (kp + 32 > qpos) p1[r] = NEG_INF; }
            }
        } else {
            const int cq = 4 * qb + (w >> 1);
            if (cq - t >= 3) { const float bc = rel[256];
#pragma unroll
                for (int r = 0; r < 16; ++r) { p0[r] += bc; p1[r] += bc; } }
            else {
#pragma unroll
                for (int r = 0; r < 16; ++r) { const int d0_ = qpos - (64 * t + crow(r, hi)); int i0 = d0_ < -128 ? -128 : (d0_ > 128 ? 128 : d0_); int i1 = d0_ - 32 < -128 ? -128 : (d0_ - 32 > 128 ? 128 : d0_ - 32);
                    p0[r] += rel[i0 + 128]; p1[r] += rel[i1 + 128]; }
            }
        }
        softmax_tile(p0, p1, m, l, o, wsf, r32, hi);
    }
    pv(o, pv_base(slot + SLOT_V, lane, hi), p0, p1);
}

template <int MODE>
__device__ __forceinline__ void prompt_unit(int hcol, int qb, const bf16* Qg, const bf16* Kg, const bf16* Vg, bf16* Og, lptr lds, const double* Dh, const float* rel, int tid_in, int t_first = 0) {
    int tid_ = tid_in; asm volatile("" : "+v"(tid_));
    const int tid = tid_, lane = tid & 63, r32 = lane & 31, hi = lane >> 5, w = __builtin_amdgcn_readfirstlane(tid >> 6);
    const int q0 = qb * 256, wq_lo = q0 + 32 * w, wq_hi = wq_lo + 31, qpos = wq_lo + r32;
    ALDS float* wsf = (ALDS float*)(lds + L_WSF) + w * 64; ALDS bf16* stg = (ALDS bf16*)(lds + L_OST + w * 4096);
    bf16x8 qr[4];
#pragma unroll
    for (int d0 = 0; d0 < 4; ++d0) qr[d0] = *(const bf16x8*)(Qg + (size_t)qpos * DM + hcol * 64 + 16 * d0 + 8 * hi);
    ALDS float* tabl = (ALDS float*)(lds + L_TAB);
    if (MODE == 1) { for (int i = tid; i < 257; i += 512) tabl[i] = rel[i] * LOG2E; }
    f32x16 o[2]; o[0] = f32x16{}; o[1] = f32x16{};
    float m = NEG_INF, l = 0.f, cum = 1.0f;
    int t0, n, step;
    if (MODE == 0) { t0 = 4 * qb + 3; n = 4 * qb + 4; step = -1; }
    else if (MODE == 2) { t0 = 4 * qb + 3; n = 4 * qb + 4 - t_first; step = -1; }
    else { t0 = 4 * qb - 8; if (t0 < 0) t0 = 0; n = 4 * qb + 4 - t0; step = 1; }
    double dref = 0.0, dk = 0.0;
    if (MODE == 2) dref = Dh[q0 + 255];
    const bf16* kbase = Kg + (size_t)lane * DM + hcol * 64 + w * 8;
    const bf16* vbase = Vg + (size_t)(16 * (w & 3) + (lane >> 2)) * DM + hcol * 64 + 32 * (w >> 2) + 8 * (lane & 3);
    u32x4 kr, vr;
#define LOADREGS(tt) do { const size_t off_ = (size_t)(tt) * 64 * DM; kr = *(const u32x4*)(kbase + off_); vr = *(const u32x4*)(vbase + off_); if (MODE == 2) dk = Dh[(tt) * 64 + lane]; } while (0)
#define WRITESLOT(sl) do { *(ALDS u32x4*)((sl) + SLOT_K + w * 1024 + lane * 16) = kr; *(ALDS u32x4*)((sl) + SLOT_V + w * 1024 + lane * 16) = vr; \
        if (MODE == 2 && w == 0) { const float b_ = (float)(dref - dk) * LOG2E; const float h_ = bf_round(b_); const float r1_ = b_ - h_; const float m_ = bf_round(r1_); const float l_ = r1_ - m_; \
            *(ALDS u32x4*)((sl) + SLOT_B + lane * 16) = (u32x4){cvtpk(h_, m_), cvtpk(l_, 0.f), 0u, 0u}; } } while (0)
#define ACTIVE(tt) ((MODE == 0) ? (64 * (tt) < wq_hi) : (MODE == 2) ? (64 * (tt) <= wq_hi) : (((tt) >= 4 * qb + (w >> 1) - 8) && ((tt) <= 4 * qb + (w >> 1))))
    lptr s_cur = lds, s_nxt = lds + SLOT_BYTES, s_wr = lds + 2 * SLOT_BYTES;
    LOADREGS(t0); WRITESLOT(s_cur);
    if (n > 1) LOADREGS(t0 + step);
    __syncthreads();
    if (n > 1) WRITESLOT(s_nxt);
    if (n > 2) LOADREGS(t0 + 2 * step);
    f32x16 c0, c1, n0, n1;
    if (ACTIVE(t0)) { qkt(c0, c1, s_cur + SLOT_K, qr, r32, hi); if (MODE == 2) qkt_bias(c0, c1, s_cur + SLOT_B, r32, hi); }
    __syncthreads();
    for (int i = 0;; ++i) {
        const int t = t0 + i * step;
        if (i + 2 < n) { WRITESLOT(s_wr); if (i + 3 < n) LOADREGS(t + 3 * step); }
        const bool act = ACTIVE(t), actn = (i + 1 < n) && ACTIVE(t + step);
        if (act && actn) {
            qkt(n0, n1, s_nxt + SLOT_K, qr, r32, hi); if (MODE == 2) qkt_bias(n0, n1, s_nxt + SLOT_B, r32, hi);
            process_tile<MODE>(c0, c1, t, qb, w, qpos, wq_lo, s_cur, tabl, m, l, cum, o, wsf, lane, r32, hi);
        } else {
            if (actn) { qkt(n0, n1, s_nxt + SLOT_K, qr, r32, hi); if (MODE == 2) qkt_bias(n0, n1, s_nxt + SLOT_B, r32, hi); }
            if (act) process_tile<MODE>(c0, c1, t, qb, w, qpos, wq_lo, s_cur, tabl, m, l, cum, o, wsf, lane, r32, hi);
        }
        const int all = __syncthreads_and(MODE == 0 ? (cum < STICK_REM_MIN ? 1 : 0) : 0);
        if (i + 1 >= n || all) break;
        c0 = n0; c1 = n1;
        const lptr tmp = s_cur; s_cur = s_nxt; s_nxt = s_wr; s_wr = tmp;
    }
#undef LOADREGS
#undef WRITESLOT
#undef ACTIVE
    float inv = 1.0f;
    if (MODE != 0) { float lo, hv; pair_vals(l, lo, hv); inv = 1.0f / (lo + hv); }
    store_o(o, inv, wsf, stg, Og + (size_t)wq_lo * DM + hcol * 64, 32, lane, r32, hi);
    __syncthreads();
}

struct SmpSrc { const float* ck; const float* cv; int L, H, hl; const bf16* Kn; const bf16* Vn; };
#ifndef STAGE_BOTH_MASK
#define STAGE_BOTH_MASK 0
#endif
template <bool BOTH = false>
__device__ __forceinline__ void stage_cache_tile(const SmpSrc& S, int tt, lptr Ks, lptr Vs, int lane_in) {
    int lane = lane_in; asm volatile("" : "+v"(lane));
    const size_t rs = (size_t)S.H * 64; const int piece = lane & 15, rsub = lane >> 4;
    size_t eoff = ((size_t)tt * 64 * S.H + S.hl) * 64 + (size_t)rsub * rs + 4 * piece;
    asm volatile("" : "+v"(eoff));
    const float* kp = S.ck + eoff; const float* vp = S.cv + eoff;
    if (BOTH) {
        f32x4 x[16], y[16];
#pragma unroll
        for (int i = 0; i < 16; ++i) x[i] = __builtin_nontemporal_load((const f32x4*)(kp + (size_t)(4 * i) * rs));
#pragma unroll
        for (int i = 0; i < 16; ++i) y[i] = __builtin_nontemporal_load((const f32x4*)(vp + (size_t)(4 * i) * rs));
#pragma unroll
        for (int i = 0; i < 16; ++i) { const int row = 4 * i + rsub; *(ALDS u32x2*)(Ks + (piece >> 1) * 1024 + row * 16 + (piece & 1) * 8) = (u32x2){cvtpk(x[i][0], x[i][1]), cvtpk(x[i][2], x[i][3])}; }
#pragma unroll
        for (int i = 0; i < 16; ++i) { const int row = 4 * i + rsub, d = 4 * piece;
            *(ALDS u32x2*)(Vs + (d >> 5) * 4096 + (row >> 4) * 1024 + (row & 15) * 64 + (d & 31) * 2) = (u32x2){cvtpk(y[i][0], y[i][1]), cvtpk(y[i][2], y[i][3])}; }
        return;
    }
    f32x4 x[16];
#pragma unroll
    for (int i = 0; i < 16; ++i) x[i] = __builtin_nontemporal_load((const f32x4*)(kp + (size_t)(4 * i) * rs));
#pragma unroll
    for (int i = 0; i < 16; ++i) { const int row = 4 * i + rsub; *(ALDS u32x2*)(Ks + (piece >> 1) * 1024 + row * 16 + (piece & 1) * 8) = (u32x2){cvtpk(x[i][0], x[i][1]), cvtpk(x[i][2], x[i][3])}; }
#pragma unroll
    for (int i = 0; i < 16; ++i) x[i] = __builtin_nontemporal_load((const f32x4*)(vp + (size_t)(4 * i) * rs));
#pragma unroll
    for (int i = 0; i < 16; ++i) { const int row = 4 * i + rsub, d = 4 * piece;
        *(ALDS u32x2*)(Vs + (d >> 5) * 4096 + (row >> 4) * 1024 + (row & 15) * 64 + (d & 31) * 2) = (u32x2){cvtpk(x[i][0], x[i][1]), cvtpk(x[i][2], x[i][3])}; }
}
__device__ __forceinline__ void stage_bf16_tile(const bf16* Kn, const bf16* Vn, int nrows, lptr Ks, lptr Vs, int lane_in) {
    int lane = lane_in; asm volatile("" : "+v"(lane));
    const int piece = lane & 7, rsub = lane >> 3;
#pragma unroll
    for (int i = 0; i < 8; ++i) { const int row = 8 * i + rsub, d = 8 * piece;
        u32x4 kx = (u32x4){0u, 0u, 0u, 0u}, vx = kx;
        if (row < nrows) { kx = *(const u32x4*)(Kn + (size_t)row * DM + d); vx = *(const u32x4*)(Vn + (size_t)row * DM + d); }
        *(ALDS u32x4*)(Ks + piece * 1024 + row * 16) = kx;
        *(ALDS u32x4*)(Vs + (d >> 5) * 4096 + (row >> 4) * 1024 + (row & 15) * 64 + (d & 31) * 2) = vx; }
}
__device__ __forceinline__ void load_bf16_tile(const bf16* Kn, const bf16* Vn, u32x4 (&kx)[8], u32x4 (&vx)[8], int lane_in) {
    int lane = lane_in; asm volatile("" : "+v"(lane));
    const int piece = lane & 7, rsub = lane >> 3;
#pragma unroll
    for (int i = 0; i < 8; ++i) { const size_t off = (size_t)(8 * i + rsub) * DM + 8 * piece; kx[i] = *(const u32x4*)(Kn + off); vx[i] = *(const u32x4*)(Vn + off); }
}
__device__ __forceinline__ void write_bf16_tile(const u32x4 (&kx)[8], const u32x4 (&vx)[8], lptr Ks, lptr Vs, int lane_in) {
    int lane = lane_in; asm volatile("" : "+v"(lane));
    const int piece = lane & 7, rsub = lane >> 3;
#pragma unroll
    for (int i = 0; i < 8; ++i) { const int row = 8 * i + rsub, d = 8 * piece;
        *(ALDS u32x4*)(Ks + piece * 1024 + row * 16) = kx[i];
        *(ALDS u32x4*)(Vs + (d >> 5) * 4096 + (row >> 4) * 1024 + (row & 15) * 64 + (d & 31) * 2) = vx[i]; }
}
__device__ __forceinline__ void stick_wave_unit(int hcol, int q32, const bf16* Qg, const bf16* Kg, const bf16* Vg, bf16* Og, lptr wl, int lane_in) {
    int lane = lane_in; asm volatile("" : "+v"(lane));
    const int r32 = lane & 31, hi = lane >> 5, q_lo = 32 * q32, qpos = q_lo + r32;
    const lptr Ks = wl + SW_K, Vs = wl + SW_V; const int vb = pv_base(Vs, lane, hi);
    const bf16* Kh = Kg + hcol * 64; const bf16* Vh = Vg + hcol * 64;
    bf16x8 qr[4];
#pragma unroll
    for (int d0 = 0; d0 < 4; ++d0) qr[d0] = *(const bf16x8*)(Qg + (size_t)qpos * DM + hcol * 64 + 16 * d0 + 8 * hi);
    f32x16 o[2]; o[0] = f32x16{}; o[1] = f32x16{}; float cum = 1.0f;
    u32x4 kx[8], vx[8];
    int t = (q_lo + 30) >> 6;
    load_bf16_tile(Kh + (size_t)t * 64 * DM, Vh + (size_t)t * 64 * DM, kx, vx, lane);
    for (; t >= 0; --t) {
        write_bf16_tile(kx, vx, Ks, Vs, lane);
        if (t > 0) load_bf16_tile(Kh + (size_t)(t - 1) * 64 * DM, Vh + (size_t)(t - 1) * 64 * DM, kx, vx, lane);
        asm volatile("s_waitcnt lgkmcnt(0)" ::: "memory");
        f32x16 p0, p1; qkt(p0, p1, Ks, qr, r32, hi);
        stick_tile(p0, p1, cum, 64 * t, qpos, 64 * t + 63 >= q_lo, 64, hi);
        pv(o, vb, p0, p1);
        asm volatile("s_waitcnt lgkmcnt(0)" ::: "memory");
        if (__all(cum < STICK_REM_MIN)) break;
    }
    store_o(o, 1.0f, (ALDS float*)(wl + SW_WSF), (ALDS bf16*)(wl + SW_K), Og + (size_t)q_lo * DM + hcol * 64, 32, lane, r32, hi);
}

__device__ __forceinline__ void band_wave_unit(int hcol, int q32, const bf16* Qg, const bf16* Kg, const bf16* Vg, bf16* Og, lptr wl, const ALDS float* tab, int lane_in) {
    int lane = lane_in; asm volatile("" : "+v"(lane));
    const int r32 = lane & 31, hi = lane >> 5, q_lo = 32 * q32, chunk = q32 >> 1;
    const lptr Ks = wl + SW_K, Vs = wl + SW_V; const int vb = pv_base(Vs, lane, hi); ALDS float* wsf = (ALDS float*)(wl + SW_WSF);
    const bf16* Kh = Kg + hcol * 64; const bf16* Vh = Vg + hcol * 64;
    bf16x8 qr[4];
#pragma unroll
    for (int d0 = 0; d0 < 4; ++d0) qr[d0] = *(const bf16x8*)(Qg + (size_t)(q_lo + r32) * DM + hcol * 64 + 16 * d0 + 8 * hi);
    f32x16 o[2]; o[0] = f32x16{}; o[1] = f32x16{}; float m = NEG_INF, l = 0.f;
    u32x4 kx[8], vx[8];
    int t = chunk - 8; if (t < 0) t = 0;
    load_bf16_tile(Kh + (size_t)t * 64 * DM, Vh + (size_t)t * 64 * DM, kx, vx, lane);
    const float bc = tab[256];
    for (; t <= chunk; ++t) {
        write_bf16_tile(kx, vx, Ks, Vs, lane);
        if (t < chunk) load_bf16_tile(Kh + (size_t)(t + 1) * 64 * DM, Vh + (size_t)(t + 1) * 64 * DM, kx, vx, lane);
        asm volatile("s_waitcnt lgkmcnt(0)" ::: "memory");
        f32x16 p0, p1; qkt(p0, p1, Ks, qr, r32, hi);
        if (chunk - t >= 3) {
#pragma unroll
            for (int r = 0; r < 16; ++r) { p0[r] += bc; p1[r] += bc; }
        } else {
            const int dq = q_lo + r32 - 64 * t;
#pragma unroll
            for (int r = 0; r < 16; ++r) { const int d0_ = dq - crow(r, hi); int i0 = d0_ < -128 ? -128 : (d0_ > 128 ? 128 : d0_); int i1 = d0_ - 32 < -128 ? -128 : (d0_ - 32 > 128 ? 128 : d0_ - 32);
                p0[r] += tab[i0 + 128]; p1[r] += tab[i1 + 128]; }
        }
        softmax_tile(p0, p1, m, l, o, wsf, r32, hi);
        pv(o, vb, p0, p1);
        asm volatile("s_waitcnt lgkmcnt(0)" ::: "memory");
    }
    float lo, hv; pair_vals(l, lo, hv);
    store_o(o, 1.0f / (lo + hv), wsf, (ALDS bf16*)(wl + SW_K), Og + (size_t)q_lo * DM + hcol * 64, 32, lane, r32, hi);
}

template <int MODE>
__device__ __forceinline__ void sample_walk(const SmpSrc& S, int t0, int step, int cnt, const bf16x8 (&qr)[4], lptr wl, const double* Db, const float* rel,
                                            f32x16 (&o)[2], float& m, float& l, float& cum, int lane, int r32, int hi) {
    const lptr Ks = wl + SW_K, Vs = wl + SW_V; ALDS float* biasl = (ALDS float*)(wl + SW_BIAS); ALDS float* wsf = (ALDS float*)(wl + SW_WSF);
    const int vb = pv_base(Vs, lane, hi); const int qpos = PAST + (r32 & 15); const int nct = S.L >> 6;
    double dref = 0.0; if (MODE == 2) dref = Db[S.L + 15];
    int t = t0;
    for (int it = 0; it < cnt; ++it, t += step) {
        int nvalid;
        if (t >= nct) { stage_bf16_tile(S.Kn, S.Vn, 16, Ks, Vs, lane); nvalid = 16; } else { stage_cache_tile<(STAGE_BOTH_MASK >> MODE) & 1>(S, t, Ks, Vs, lane); nvalid = 64; }
        const int kpos0 = (PAST - S.L) + 64 * t;
        if (MODE == 2) biasl[lane] = (lane < nvalid) ? (float)(dref - Db[64 * t + lane]) * LOG2E : 0.f;
        asm volatile("s_waitcnt lgkmcnt(0)" ::: "memory");
        const bool need_mask = (t >= nct);
        f32x16 p0, p1; qkt(p0, p1, Ks, qr, r32, hi);
        if (MODE == 0) stick_tile(p0, p1, cum, kpos0, qpos, need_mask, nvalid, hi);
        else {
            if (MODE == 2) {
#pragma unroll
                for (int q4 = 0; q4 < 4; ++q4) { const f32x4 b0 = *(const ALDS f32x4*)(biasl + 8 * q4 + 4 * hi), b1 = *(const ALDS f32x4*)(biasl + 32 + 8 * q4 + 4 * hi);
#pragma unroll
                    for (int i = 0; i < 4; ++i) { p0[4 * q4 + i] += b0[i]; p1[4 * q4 + i] += b1[i]; } }
            } else {
#pragma unroll
                for (int r = 0; r < 16; ++r) { const int d0_ = qpos - (kpos0 + crow(r, hi)); int i0 = d0_ < -128 ? -128 : (d0_ > 128 ? 128 : d0_); int i1 = d0_ - 32 < -128 ? -128 : (d0_ - 32 > 128 ? 128 : d0_ - 32);
                    p0[r] += rel[i0 + 128] * LOG2E; p1[r] += rel[i1 + 128] * LOG2E; }
            }
            if (need_mask) {
#pragma unroll
                for (int r = 0; r < 16; ++r) { const int kk = crow(r, hi); const bool v0 = (kk < nvalid) && (MODE == 1 || kpos0 + kk <= qpos); const bool v1 = (kk + 32 < nvalid) && (MODE == 1 || kpos0 + kk + 32 <= qpos);
                    if (!v0) p0[r] = NEG_INF; if (!v1) p1[r] = NEG_INF; }
            }
            softmax_tile(p0, p1, m, l, o, wsf, r32, hi);
        }
        pv(o, vb, p0, p1);
        asm volatile("s_waitcnt lgkmcnt(0)" ::: "memory");
        if (MODE == 0 && __all(cum < STICK_REM_MIN)) break;
    }
}
__device__ __forceinline__ void load_q_sample(bf16x8 (&qr)[4], const bf16* Qg, int b, int hcol, int r32, int hi) {
#pragma unroll
    for (int d0 = 0; d0 < 4; ++d0) qr[d0] = *(const bf16x8*)(Qg + (size_t)(SEQ + b * 16 + (r32 & 15)) * DM + hcol * 64 + 16 * d0 + 8 * hi);
}
template <int MODE>
__device__ __forceinline__ void sample_unit_wave(const SmpSrc& S, int b, int hcol, const bf16* Qg, bf16* Og, lptr wl, const float* rel, int lane) {
    const int r32 = lane & 31, hi = lane >> 5; const int nt = (S.L >> 6) + 1;
    bf16x8 qr[4]; load_q_sample(qr, Qg, b, hcol, r32, hi);
    f32x16 o[2]; o[0] = f32x16{}; o[1] = f32x16{}; float m = NEG_INF, l = 0.f, cum = 1.0f;
    if (MODE == 0) sample_walk<0>(S, nt - 1, -1, nt, qr, wl, nullptr, rel, o, m, l, cum, lane, r32, hi);
    else sample_walk<1>(S, 0, 1, nt, qr, wl, nullptr, rel, o, m, l, cum, lane, r32, hi);
    float inv = 1.0f;
    if (MODE != 0) { float lo, hv; pair_vals(l, lo, hv); inv = 1.0f / (lo + hv); }
    store_o(o, inv, (ALDS float*)(wl + SW_WSF), (ALDS bf16*)(wl + SW_K), Og + (size_t)(SEQ + b * 16) * DM + hcol * 64, 16, lane, r32, hi);
}
__device__ __forceinline__ void sample_unit_stick_pre(const SmpSrc& S, int b, int hcol, const bf16* Qg, bf16* Og, lptr lds, int wave, int lane) {
    const int nct = S.L >> 6;
    if (wave == 0) stage_bf16_tile(S.Kn, S.Vn, 16, lds + SW_K, lds + SW_V, lane);
    else stage_cache_tile(S, nct - wave, lds + wave * SW_BYTES + SW_K, lds + wave * SW_BYTES + SW_V, lane);
    asm volatile("s_waitcnt lgkmcnt(0)" ::: "memory");
    __syncthreads();
    if (wave == 0) {
        const int r32 = lane & 31, hi = lane >> 5; const int qpos = PAST + (r32 & 15);
        bf16x8 qr[4]; load_q_sample(qr, Qg, b, hcol, r32, hi);
        f32x16 o[2]; o[0] = f32x16{}; o[1] = f32x16{}; float cum = 1.0f;
        for (int it = 0; it <= nct; ++it) {
            const int t = nct - it; int reg = (it <= 7) ? it : 0; asm volatile("" : "+s"(reg));
            const lptr Ks = lds + reg * SW_BYTES + SW_K, Vs = lds + reg * SW_BYTES + SW_V;
            if (it > 7) { stage_cache_tile(S, t, Ks, Vs, lane); asm volatile("s_waitcnt lgkmcnt(0)" ::: "memory"); }
            const int kpos0 = (PAST - S.L) + 64 * t;
            f32x16 p0, p1; qkt(p0, p1, Ks, qr, r32, hi);
            stick_tile(p0, p1, cum, kpos0, qpos, it == 0, it == 0 ? 16 : 64, hi);
            pv(o, pv_base(Vs, lane, hi), p0, p1);
            asm volatile("s_waitcnt lgkmcnt(0)" ::: "memory");
            if (__all(cum < STICK_REM_MIN)) break;
        }
        store_o(o, 1.0f, (ALDS float*)(lds + SW_WSF), (ALDS bf16*)(lds + SW_K), Og + (size_t)(SEQ + b * 16) * DM + hcol * 64, 16, lane, r32, hi);
    }
}
template <int MODE>
__device__ __forceinline__ void sample_unit_split(const SmpSrc& S, int b, int hcol, const bf16* Qg, bf16* Og, lptr lds, const double* Db, const float* rel, int tid_in) {
    int tid_ = tid_in; asm volatile("" : "+v"(tid_));
    const int tid = tid_, lane = tid & 63, r32 = lane & 31, hi = lane >> 5, w = __builtin_amdgcn_readfirstlane(tid >> 6);
    const lptr wl = lds + w * SW_BYTES;
    const int nt = (S.L >> 6) + 1, per = nt >> 3;
    bf16x8 qr[4]; load_q_sample(qr, Qg, b, hcol, r32, hi);
    f32x16 o[2]; o[0] = f32x16{}; o[1] = f32x16{}; float m = NEG_INF, l = 0.f, cum = 1.0f;
    sample_walk<MODE>(S, per * w, 1, (w == 7) ? nt - 7 * per : per, qr, wl, Db, rel, o, m, l, cum, lane, r32, hi);
    ALDS float* pm = (ALDS float*)wl; ALDS float* pl = pm + 16; ALDS float* po = pm + 32;
    { float lo, hv; pair_vals(l, lo, hv); if (lane < 16) { pm[lane] = m; pl[lane] = lo + hv; } }
#pragma unroll
    for (int r = 0; r < 8; ++r) { const int q = crow(r, hi);
#pragma unroll
        for (int d0 = 0; d0 < 2; ++d0) po[q * 64 + d0 * 32 + r32] = o[d0][r]; }
    __syncthreads();
    { const int q = tid >> 5, d = (tid & 31) * 2;
      float M = NEG_INF;
#pragma unroll
      for (int ww = 0; ww < 8; ++ww) M = fmaxf(M, ((ALDS float*)(lds + ww * SW_BYTES))[q]);
      float den = 0.f, n0 = 0.f, n1 = 0.f;
#pragma unroll
      for (int ww = 0; ww < 8; ++ww) { ALDS float* base = (ALDS float*)(lds + ww * SW_BYTES); const float f = ex2(base[q] - M); den += base[16 + q] * f; n0 += base[32 + q * 64 + d] * f; n1 += base[32 + q * 64 + d + 1] * f; }
      const float inv = 1.0f / den;
      *(unsigned*)(Og + (size_t)(SEQ + b * 16 + q) * DM + hcol * 64 + d) = cvtpk(n0 * inv, n1 * inv); }
    __syncthreads();
}
}

#ifndef FORGET_SHFL_SCAN
#define FORGET_SHFL_SCAN 0
#endif
#ifndef EXP_UNROLL_ODD
#define EXP_UNROLL_ODD 16
#endif
#ifndef EXP_UNROLL_EVEN
#define EXP_UNROLL_EVEN 8
#endif
namespace smm {
using att::bf16; using att::bf16x8; using att::f32x16; using att::f32x4; using att::u32x4; using att::lptr; using att::crow;
typedef pg8::bf16_t bf16_t;
typedef float f32x4v __attribute__((ext_vector_type(4)));
template <int CH>
__device__ __forceinline__ void kload(bf16x8 (&af)[CH][2], bf16x8 (&bf)[CH][2], const bf16* A0, size_t lda, const bf16* B0, const bf16* B1, int kc) {
#pragma unroll
    for (int s = 0; s < CH; ++s) {
        af[s][0] = *(const bf16x8*)(A0 + kc + 16 * s); af[s][1] = *(const bf16x8*)(A0 + 32 * lda + kc + 16 * s);
        bf[s][0] = *(const bf16x8*)(B0 + kc + 16 * s); bf[s][1] = *(const bf16x8*)(B1 + kc + 16 * s);
    }
}
template <int CH>
__device__ __forceinline__ void kmma(f32x16 (&acc)[2][2], const bf16x8 (&af)[CH][2], const bf16x8 (&bf)[CH][2]) {
#pragma unroll
    for (int s = 0; s < CH; ++s)
#pragma unroll
        for (int i = 0; i < 2; ++i)
#pragma unroll
            for (int j = 0; j < 2; ++j) acc[i][j] = __builtin_amdgcn_mfma_f32_32x32x16_bf16(af[s][i], bf[s][j], acc[i][j], 0, 0, 0);
}
template <int CH>
__device__ __forceinline__ void kloop(f32x16 (&acc)[2][2], const bf16* A0, size_t lda, const bf16* B0, const bf16* B1, int k0, int klen) {
    bf16x8 a0[CH][2], b0[CH][2], a1[CH][2], b1[CH][2];
    const int kend = k0 + klen;
    kload<CH>(a0, b0, A0, lda, B0, B1, k0);
    for (int kc = k0; kc < kend; kc += 32 * CH) {
        if (kc + 16 * CH < kend) kload<CH>(a1, b1, A0, lda, B0, B1, kc + 16 * CH);
        kmma<CH>(acc, a0, b0);
        if (kc + 16 * CH < kend) {
            if (kc + 32 * CH < kend) kload<CH>(a0, b0, A0, lda, B0, B1, kc + 32 * CH);
            kmma<CH>(acc, a1, b1);
        }
    }
}
__device__ __forceinline__ void reduce8(const f32x16 (&acc)[2][2], lptr lds, int tid, int w, int r32, int hi, float (&v)[8]) {
    ALDS float* part = (ALDS float*)lds + w * 4096;
#pragma unroll
    for (int i = 0; i < 2; ++i)
#pragma unroll
        for (int j = 0; j < 2; ++j)
#pragma unroll
            for (int r = 0; r < 16; ++r) part[(32 * i + crow(r, hi)) * 64 + 32 * j + r32] = acc[i][j][r];
    __syncthreads();
    const int row = tid >> 3, cg = tid & 7;
    f32x4 s0 = (f32x4){0.f, 0.f, 0.f, 0.f}, s1 = s0;
#pragma unroll
    for (int ww = 0; ww < 8; ++ww) { const ALDS float* p = (const ALDS float*)lds + ww * 4096 + row * 64 + 8 * cg; s0 += *(const ALDS f32x4*)p; s1 += *(const ALDS f32x4*)(p + 4); }
    __syncthreads();
#pragma unroll
    for (int i = 0; i < 4; ++i) { v[i] = s0[i]; v[4 + i] = s1[i]; }
}
__device__ __forceinline__ float sum8sq(const float (&v)[8]) { return ((v[0] * v[0] + v[1] * v[1]) + (v[2] * v[2] + v[3] * v[3])) + ((v[4] * v[4] + v[5] * v[5]) + (v[6] * v[6] + v[7] * v[7])); }
__device__ __forceinline__ float xor8(float s) { s += __shfl_xor(s, 1); s += __shfl_xor(s, 2); s += __shfl_xor(s, 4); return s; }
__device__ __forceinline__ u32x4 pack8v(const float (&v)[8]) { return (u32x4){pg8::cvt_pk_bf16(v[0], v[1]), pg8::cvt_pk_bf16(v[2], v[3]), pg8::cvt_pk_bf16(v[4], v[5]), pg8::cvt_pk_bf16(v[6], v[7])}; }
#define SMM_IDS int tid_ = tid_in; asm volatile("" : "+v"(tid_)); const int tid = tid_, lane = tid & 63, r32 = lane & 31, hi = lane >> 5, w = __builtin_amdgcn_readfirstlane(tid >> 6); (void)lane
#define SMM_ZERO(acc) do { _Pragma("unroll") for (int i_ = 0; i_ < 2; ++i_) _Pragma("unroll") for (int j_ = 0; j_ < 2; ++j_) acc[i_][j_] = f32x16{}; } while (0)

__device__ __forceinline__ void in_proj(const bf16* HB, const bf16* W, const float* ssq, bf16_t* Qb, float* out, const float* gq, const float* gk, const float* bfg, int odd, int j,
                                        float* LPt  , double* Tt  , lptr lds, int bx, int G, int tid_in) {
    SMM_IDS;
    const int nu = odd ? 192 + 4 + 256 : 192;
    for (int u = bx; u < nu; u += G) {
        int ct, row0;
        if (u < 192) { ct = u >> 2; row0 = SEQ + 64 * (u & 3); } else { ct = 48; const int fu = u - 192; row0 = (fu < 4) ? SEQ + 64 * fu : 64 * (fu - 4); }
        const int brow0 = (ct < 48) ? 256 * (ct >> 2) + 32 * (ct & 3) : 3072, brow1 = (ct < 48) ? brow0 + 128 : 3104;
        const int row = row0 + (tid >> 3), cg = tid & 7; const float r = pg8::row_rscale(ssq, row);
        f32x16 acc[2][2]; SMM_ZERO(acc);
        kloop<4>(acc, HB + (size_t)(row0 + r32) * DM + 8 * hi, DM, W + (size_t)(brow0 + r32) * DM + 8 * hi, W + (size_t)(brow1 + r32) * DM + 8 * hi, 128 * w, 128);
        float v[8]; reduce8(acc, lds, tid, w, r32, hi, v);
#pragma unroll
        for (int i = 0; i < 8; ++i) v[i] *= r;
        if (ct == 48) {
            float y[8];
            if (cg < 2) {
#pragma unroll
                for (int i = 0; i < 8; ++i) y[i] = pg8::log_sigmoid_f(v[i] + bfg[8 * cg + i]);
                float* dst = out + (row >= SEQ ? O_SCF + (size_t)(j * NSMP + row - SEQ) * 16 : O_PCF + ((size_t)j * SEQ + row) * 16) + 8 * cg;
                *(f32x4*)dst = (f32x4){y[0], y[1], y[2], y[3]}; *(f32x4*)(dst + 4) = (f32x4){y[4], y[5], y[6], y[7]}; }
            if (row0 < SEQ) {
                ALDS float* fl = (ALDS float*)lds;
                if (cg < 2) {
#pragma unroll
                    for (int i = 0; i < 8; ++i) fl[(8 * cg + i) * 64 + (tid >> 3)] = y[i]; }
                __syncthreads();
#if FORGET_SHFL_SCAN
#pragma unroll
                for (int hh = 0; hh < 2; ++hh) {
                    const int hd_ = 2 * w + hh; double x_ = (double)fl[hd_ * 64 + lane];
#pragma unroll
                    for (int o_ = 1; o_ < 64; o_ <<= 1) { const double t_ = __shfl_up(x_, o_); if (lane >= o_) x_ += t_; }
                    fl[hd_ * 64 + lane] = (float)x_;
                    if (lane == 63) Tt[hd_ * 256 + (row0 >> 6)] = x_; }
#else
                if (tid < 16) { double run = 0.0;
                    for (int r = 0; r < 64; ++r) { run += (double)fl[tid * 64 + r]; fl[tid * 64 + r] = (float)run; }
                    Tt[tid * 256 + (row0 >> 6)] = run; }
#endif
                __syncthreads();
                if (tid < 256) *(f32x4*)(LPt + (size_t)(tid >> 4) * SEQ + row0 + 4 * (tid & 15)) = *(const ALDS f32x4*)(fl + (tid >> 4) * 64 + 4 * (tid & 15));
                __syncthreads();
            }
            continue;
        }
        const int t = ct >> 4, hd = ct & 15;
        if ((t < 2) && (odd || hd >= 8)) {
            const float rs = pg8::rsq_f(xor8(sum8sq(v)) * (1.0f / 64.0f) + RMS_EPS); const float* g = (t == 0 ? gq : gk) + 8 * cg;
#pragma unroll
            for (int i = 0; i < 8; ++i) v[i] = v[i] * rs * g[i];
        }
        bf16_t* orow = Qb + (size_t)t * ((size_t)MROWS * DM) + (size_t)row * DM + hd * 64 + 8 * cg;
        if (t == 0) {
#pragma unroll
            for (int i = 0; i < 8; ++i) v[i] *= QSCALE;
            *(u32x4*)orow = pack8v(v);
        } else {
            *(u32x4*)orow = pack8v(v);
            float* fo = pg8::kv_dst(out, odd, j, t, hd, row) + 8 * cg;
            *(f32x4*)fo = (f32x4){v[0], v[1], v[2], v[3]}; *(f32x4*)(fo + 4) = (f32x4){v[4], v[5], v[6], v[7]};
        }
    }
}
__device__ __forceinline__ void residual(const bf16* A, const bf16* W, int kdim, const bf16_t* hb_in, bf16_t* hb_out, float* ssq, lptr lds, int bx, int G, int tid_in) {
    SMM_IDS;
    for (int u = bx; u < 64; u += G) {
        const int rb = u & 3, ct = u >> 2, row0 = SEQ + 64 * rb, c0 = 64 * ct;
        f32x16 acc[2][2]; SMM_ZERO(acc);
        kloop<4>(acc, A + (size_t)(row0 + r32) * kdim + 8 * hi, (size_t)kdim, W + (size_t)(c0 + r32) * kdim + 8 * hi, W + (size_t)(c0 + 32 + r32) * kdim + 8 * hi, (kdim >> 3) * w, kdim >> 3);
        float v[8]; reduce8(acc, lds, tid, w, r32, hi, v);
        const int row = row0 + (tid >> 3), cg = tid & 7; const size_t off = (size_t)row * DM + c0 + 8 * cg;
        f32x4 h0, h1; pg8::unpack8(*(const u32x4*)(hb_in + off), h0, h1);
#pragma unroll
        for (int i = 0; i < 4; ++i) { v[i] += h0[i]; v[4 + i] += h1[i]; }
        *(u32x4*)(hb_out + off) = pack8v(v);
        const float s = xor8(sum8sq(v));
        if (cg == 0) ssq[(size_t)row * 16 + ct] = s;
    }
}
__device__ __forceinline__ void ff1(const bf16* HB, const bf16* W, const float* ssq, bf16_t* hid, lptr lds, int bx, int G, int tid_in) {
    SMM_IDS;
    for (int u = bx; u < 256; u += G) {
        const int rb = u & 3, ct = u >> 2, row0 = SEQ + 64 * rb, c0 = 64 * ct;
        const int row = row0 + (tid >> 3), cg = tid & 7; const float r = pg8::row_rscale(ssq, row);
        f32x16 acc[2][2]; SMM_ZERO(acc);
        kloop<4>(acc, HB + (size_t)(row0 + r32) * DM + 8 * hi, DM, W + (size_t)(c0 + r32) * DM + 8 * hi, W + (size_t)(c0 + 32 + r32) * DM + 8 * hi, 128 * w, 128);
        float v[8]; reduce8(acc, lds, tid, w, r32, hi, v);
#pragma unroll
        for (int i = 0; i < 8; ++i) { const float x = fmaxf(v[i] * r, 0.f); v[i] = x * x; }
        *(u32x4*)(hid + (size_t)row * FF + c0 + 8 * cg) = pack8v(v);
    }
}
__device__ __forceinline__ void ple(const bf16* HB, const bf16* Wg, const bf16* PB, const bf16* Wp, const float* ssq_in, bf16_t* hb, float* ssq_out, float* yout  ,
                                    lptr lds, int bx, int G, int tid_in) {
    SMM_IDS;
    for (int u = bx; u < 64; u += G) {
        const int rb = u & 3, ct = u >> 2, row0 = SEQ + 64 * rb, c0 = 64 * ct;
        f32x16 acc[2][2]; SMM_ZERO(acc);
        kloop<2>(acc, PB + (size_t)(row0 + r32) * DPLE + 8 * hi, DPLE, Wp + (size_t)(c0 + r32) * DPLE + 8 * hi, Wp + (size_t)(c0 + 32 + r32) * DPLE + 8 * hi, 32 * w, 32);
        float pj[8]; reduce8(acc, lds, tid, w, r32, hi, pj);
        SMM_ZERO(acc);
        kloop<4>(acc, HB + (size_t)(row0 + r32) * DM + 8 * hi, DM, Wg + (size_t)(c0 + r32) * DM + 8 * hi, Wg + (size_t)(c0 + 32 + r32) * DM + 8 * hi, 128 * w, 128);
        float v[8]; reduce8(acc, lds, tid, w, r32, hi, v);
        const int row = row0 + (tid >> 3), cg = tid & 7; const float r = pg8::row_rscale(ssq_in, row); const size_t off = (size_t)row * DM + c0 + 8 * cg;
        f32x4 h0, h1; pg8::unpack8(*(const u32x4*)(HB + off), h0, h1);
#pragma unroll
        for (int i = 0; i < 8; ++i) v[i] = (i < 4 ? h0[i] : h1[i - 4]) + __builtin_amdgcn_rcpf(1.0f + __builtin_amdgcn_exp2f(-LOG2E * r * v[i])) * pj[i];
        if (yout) { float* yo = yout + (size_t)(row - SEQ) * DM + c0 + 8 * cg; *(f32x4*)yo = (f32x4){v[0], v[1], v[2], v[3]}; *(f32x4*)(yo + 4) = (f32x4){v[4], v[5], v[6], v[7]}; }
        *(u32x4*)(hb + off) = pack8v(v);
        const float s = xor8(sum8sq(v));
        if (cg == 0) ssq_out[(size_t)row * 16 + ct] = s;
    }
}
template <int ST>
__device__ __forceinline__ void kloop16(f32x4v (&acc)[4], const bf16* A0  , const bf16* B0  , size_t ldb, int k0, int klen) {
    for (int kc = k0; kc < k0 + klen; kc += 32 * ST) {
        bf16x8 af[ST], bf[ST][4];
#pragma unroll
        for (int s = 0; s < ST; ++s) { af[s] = *(const bf16x8*)(A0 + kc + 32 * s);
#pragma unroll
            for (int jn = 0; jn < 4; ++jn) bf[s][jn] = *(const bf16x8*)(B0 + (size_t)(16 * jn) * ldb + kc + 32 * s); }
#pragma unroll
        for (int s = 0; s < ST; ++s)
#pragma unroll
            for (int jn = 0; jn < 4; ++jn) acc[jn] = __builtin_amdgcn_mfma_f32_16x16x32_bf16(af[s], bf[s][jn], acc[jn], 0, 0, 0);
    }
}
__device__ __forceinline__ void reduce16(const f32x4v (&acc)[4], lptr lds, int tid, int w, int lane, float (&v)[8]) {
    ALDS float* part = (ALDS float*)lds + w * 1024;
#pragma unroll
    for (int jn = 0; jn < 4; ++jn)
#pragma unroll
        for (int r = 0; r < 4; ++r) part[(4 * (lane >> 4) + r) * 64 + 16 * jn + (lane & 15)] = acc[jn][r];
    __syncthreads();
    f32x4 s0 = (f32x4){0.f, 0.f, 0.f, 0.f}, s1 = s0;
    if (tid < 128) { const int row = tid >> 3, cg = tid & 7;
#pragma unroll
        for (int ww = 0; ww < 8; ++ww) { const ALDS float* p = (const ALDS float*)lds + ww * 1024 + row * 64 + 8 * cg; s0 += *(const ALDS f32x4*)p; s1 += *(const ALDS f32x4*)(p + 4); } }
    __syncthreads();
#pragma unroll
    for (int i = 0; i < 4; ++i) { v[i] = s0[i]; v[4 + i] = s1[i]; }
}
#define SMM_ZERO16(acc) do { _Pragma("unroll") for (int j_ = 0; j_ < 4; ++j_) acc[j_] = (f32x4v){0.f, 0.f, 0.f, 0.f}; } while (0)
template <int R16_ST>
__device__ __forceinline__ void residual16(const bf16* A, const bf16* W, int kdim, const bf16_t* hb_in, bf16_t* hb_out, float* ssq, lptr lds, int bx, int G, int tid_in) {
    SMM_IDS; (void)r32; (void)hi;
    for (int u = bx; u < 256; u += G) {
        const int row0 = SEQ + 16 * (u & 15), ct = u >> 4, c0 = 64 * ct;
        const int row = row0 + ((tid & 127) >> 3), cg = tid & 7; const size_t off = (size_t)row * DM + c0 + 8 * cg;
        const u32x4 hw = *(const u32x4*)(hb_in + off);
        f32x4v acc[4]; SMM_ZERO16(acc);
        kloop16<R16_ST>(acc, A + (size_t)(row0 + (lane & 15)) * kdim + 8 * (lane >> 4), W + (size_t)(c0 + (lane & 15)) * kdim + 8 * (lane >> 4), (size_t)kdim, (kdim >> 3) * w, kdim >> 3);
        float v[8]; reduce16(acc, lds, tid, w, lane, v);
        if (tid < 128) {
            f32x4 h0, h1; pg8::unpack8(hw, h0, h1);
#pragma unroll
            for (int i = 0; i < 4; ++i) { v[i] += h0[i]; v[4 + i] += h1[i]; }
            *(u32x4*)(hb_out + off) = pack8v(v);
            const float s = xor8(sum8sq(v));
            if (cg == 0) ssq[(size_t)row * 16 + ct] = s;
        }
    }
}
__device__ __forceinline__ void ple16(const bf16* HB, const bf16* Wg, const bf16* PB, const bf16* Wp, const float* ssq_in, bf16_t* hb, float* ssq_out, float* yout  ,
                                      lptr lds, int bx, int G, int tid_in) {
    SMM_IDS; (void)r32; (void)hi;
    for (int u = bx; u < 256; u += G) {
        const int row0 = SEQ + 16 * (u & 15), ct = u >> 4, c0 = 64 * ct;
        const int row = row0 + ((tid & 127) >> 3), cg = tid & 7; const size_t off = (size_t)row * DM + c0 + 8 * cg;
        const float r = pg8::row_rscale(ssq_in, row); const u32x4 hw = *(const u32x4*)(HB + off);
        f32x4v acc[4]; SMM_ZERO16(acc);
        kloop16<1>(acc, PB + (size_t)(row0 + (lane & 15)) * DPLE + 8 * (lane >> 4), Wp + (size_t)(c0 + (lane & 15)) * DPLE + 8 * (lane >> 4), DPLE, 32 * w, 32);
        float pj[8]; reduce16(acc, lds, tid, w, lane, pj);
        SMM_ZERO16(acc);
        kloop16<4>(acc, HB + (size_t)(row0 + (lane & 15)) * DM + 8 * (lane >> 4), Wg + (size_t)(c0 + (lane & 15)) * DM + 8 * (lane >> 4), DM, 128 * w, 128);
        float v[8]; reduce16(acc, lds, tid, w, lane, v);
        if (tid < 128) {
            f32x4 h0, h1; pg8::unpack8(hw, h0, h1);
#pragma unroll
            for (int i = 0; i < 8; ++i) v[i] = (i < 4 ? h0[i] : h1[i - 4]) + __builtin_amdgcn_rcpf(1.0f + __builtin_amdgcn_exp2f(-LOG2E * r * v[i])) * pj[i];
            if (yout) { float* yo = yout + (size_t)(row - SEQ) * DM + c0 + 8 * cg; *(f32x4*)yo = (f32x4){v[0], v[1], v[2], v[3]}; *(f32x4*)(yo + 4) = (f32x4){v[4], v[5], v[6], v[7]}; }
            *(u32x4*)(hb + off) = pack8v(v);
            const float s = xor8(sum8sq(v));
            if (cg == 0) ssq_out[(size_t)row * 16 + ct] = s;
        }
    }
}
__device__ __forceinline__ void expand_kv(int u, const bf16_t* Kb  , float* out, int odd, int j, int tid) {
    const int tz = u >> 8, rb = u & 255; const bf16_t* src = Kb + (size_t)tz * ((size_t)MROWS * DM);
    if (odd) {
        float* dst = out + (tz ? O_PCV : O_PCK) + (size_t)j * SEQ * 1024;
#pragma unroll EXP_UNROLL_ODD
        for (int it = 0; it < 16; ++it) { const int idx = it * 512 + tid, row = 64 * rb + (idx >> 7), c = (idx & 127) * 8;
            f32x4 a, b_; pg8::unpack8(*(const u32x4*)(src + (size_t)row * DM + c), a, b_);
            float* d = dst + (size_t)row * 1024 + c; __builtin_nontemporal_store(a, (f32x4*)d); __builtin_nontemporal_store(b_, (f32x4*)(d + 4)); }
    } else {
        float* dst = out + (tz ? O_PAV : O_PAK) + (size_t)j * SEQ * 512;
#pragma unroll EXP_UNROLL_EVEN
        for (int it = 0; it < 8; ++it) { const int idx = it * 512 + tid, row = 64 * rb + (idx >> 6), c = (idx & 63) * 8;
            f32x4 a, b_; pg8::unpack8(*(const u32x4*)(src + (size_t)row * DM + c), a, b_);
            float* d = dst + (size_t)row * 512 + c; __builtin_nontemporal_store(a, (f32x4*)d); __builtin_nontemporal_store(b_, (f32x4*)(d + 4)); }
        if (rb >= 248) {
            float* dstb = out + (tz ? O_PBV : O_PBK) + (size_t)j * 512 * 512;
#pragma unroll EXP_UNROLL_EVEN
            for (int it = 0; it < 8; ++it) { const int idx = it * 512 + tid, row = 64 * rb + (idx >> 6), c = (idx & 63) * 8;
                f32x4 a, b_; pg8::unpack8(*(const u32x4*)(src + (size_t)row * DM + 512 + c), a, b_);
                float* d = dstb + (size_t)(row - (SEQ - 512)) * 512 + c; __builtin_nontemporal_store(a, (f32x4*)d); __builtin_nontemporal_store(b_, (f32x4*)(d + 4)); }
        }
    }
}
__device__ __forceinline__ void expand_kv_even_waves(int u, const bf16_t* Kb, float* out, int j, int lane, int vw, int nw) {
    const int tz = u >> 8, rb = u & 255; const bf16_t* src = Kb + (size_t)tz * ((size_t)MROWS * DM);
    float* dst = out + (tz ? O_PAV : O_PAK) + (size_t)j * SEQ * 512; const int c = lane * 8;
#pragma unroll 2
    for (int r = vw; r < 64; r += nw) { const int row = 64 * rb + r;
        f32x4 a, b_; pg8::unpack8(*(const u32x4*)(src + (size_t)row * DM + c), a, b_);
        float* d = dst + (size_t)row * 512 + c; __builtin_nontemporal_store(a, (f32x4*)d); __builtin_nontemporal_store(b_, (f32x4*)(d + 4)); }
    if (rb >= 248) {
        float* dstb = out + (tz ? O_PBV : O_PBK) + (size_t)j * 512 * 512;
#pragma unroll 2
        for (int r = vw; r < 64; r += nw) { const int row = 64 * rb + r;
            f32x4 a, b_; pg8::unpack8(*(const u32x4*)(src + (size_t)row * DM + 512 + c), a, b_);
            float* d = dstb + (size_t)(row - (SEQ - 512)) * 512 + c; __builtin_nontemporal_store(a, (f32x4*)d); __builtin_nontemporal_store(b_, (f32x4*)(d + 4)); }
    }
}
#undef SMM_IDS
#undef SMM_ZERO
}

#include <hip/hip_bf16.h>
namespace fox {
#define FLDS __attribute__((address_space(3)))
using bf16=__hip_bfloat16;
using bf16x8=__attribute__((ext_vector_type(8)))short;
using s16x4=__attribute__((ext_vector_type(4)))short;
using f32x16=__attribute__((ext_vector_type(16)))float;
using u32x4=__attribute__((ext_vector_type(4)))unsigned;
constexpr int BATCH=1,NHEAD=16,SEQ=16384,D=64,DM=NHEAD*D;
constexpr int NW=8,QBLK=32,QB=QBLK*NW,KVBLK=64,NQB=SEQ/QB;
constexpr int ATTN_PITCH=DM, ATTN_UNIT_ROWS=QB;
__device__ __forceinline__ int crow(int r,int hi){return (r&3)+8*(r>>2)+4*hi;}
#define SBAR() __builtin_amdgcn_sched_barrier(0)
__device__ __forceinline__ void cmask(f32x16&p0,f32x16&p1,int jb,int qrel,int hi){
  const float NEG=-INFINITY; int kb=64*jb+4*hi;
  #pragma unroll
  for(int r=0;r<16;++r){int kv=kb+(r&3)+8*(r>>2); if(kv>qrel)p0[r]=NEG; if(kv+32>qrel)p1[r]=NEG;}
}

constexpr int NSLOT=3, SLOTB=8192;
constexpr int LDS_K=0, LDS_V=NSLOT*SLOTB, LDS_WS=2*NSLOT*SLOTB, LDS_OST=LDS_WS+NW*64*4, LDS_BT=LDS_OST,LDS_BYTES=LDS_BT+65536;
constexpr float C2=0.125f*1.4426950408889634f;
__device__ __forceinline__ void glds16(const void*gsrc,unsigned lds_dst){unsigned keep;
  asm volatile("s_mov_b32 %0, m0\n\ts_mov_b32 m0, %2\n\ts_nop 0\n\tglobal_load_lds_dwordx4 %1, off\n\ts_mov_b32 m0, %0":"=&s"(keep):"v"(gsrc),"s"(lds_dst):"memory");}
__device__ __forceinline__ float max3f(float a,float b,float c){float r;asm("v_max3_f32 %0, %1, %2, %3":"=v"(r):"v"(a),"v"(b),"v"(c));return r;}
__device__ __forceinline__ float max2f(float a,float b){float r;asm("v_max_f32_e32 %0, %1, %2":"=v"(r):"v"(a),"v"(b));return r;}
__device__ __forceinline__ float fadd_s(float a,float b){float r;asm("v_add_f32_e32 %0, %1, %2":"=v"(r):"v"(a),"v"(b));return r;}
__device__ __forceinline__ float fsub_s(float a,float b){float r;asm("v_sub_f32_e32 %0, %1, %2":"=v"(r):"v"(a),"v"(b));return r;}
typedef float f32x2_t __attribute__((ext_vector_type(2))); typedef __bf16 bf16x2_t __attribute__((ext_vector_type(2)));
__device__ __forceinline__ unsigned cvtpk_s(float lo,float hi){f32x2_t v={lo,hi};bf16x2_t b=__builtin_convertvector(v,bf16x2_t);return __builtin_bit_cast(unsigned,b);}
#define WAIT_BAR(N) asm volatile("s_waitcnt vmcnt(" #N ") lgkmcnt(0)\n\ts_barrier":::"memory")

typedef short s16x4b __attribute__((ext_vector_type(4)));
#define BIASK(C,AB,BQ) C=__builtin_amdgcn_mfma_f32_32x32x8bf16_1k(AB,BQ,C,0,0,0)
__device__ __forceinline__ void qkt(f32x16&p0,f32x16&p1,const FLDS char*Kslot,const bf16x8*qr,s16x4b ab0,s16x4b ab1,s16x4b bq,int r32,int hi){
  const f32x16 zz=f32x16{};
  const FLDS char*kb=Kslot+hi*1024+r32*16;
  #pragma unroll
  for(int d0=0;d0<4;++d0){
    const bf16x8 b0=*(const FLDS bf16x8*)(kb+d0*2048);
    const bf16x8 b1=*(const FLDS bf16x8*)(kb+d0*2048+512);
    if(d0==0){p0=__builtin_amdgcn_mfma_f32_32x32x16_bf16(b0,qr[0],zz,0,0,0);p1=__builtin_amdgcn_mfma_f32_32x32x16_bf16(b1,qr[0],zz,0,0,0);}
    else{p0=__builtin_amdgcn_mfma_f32_32x32x16_bf16(b0,qr[d0],p0,0,0,0);p1=__builtin_amdgcn_mfma_f32_32x32x16_bf16(b1,qr[d0],p1,0,0,0);}}
  BIASK(p0,ab0,bq);BIASK(p1,ab1,bq);
}
typedef __attribute__((address_space(3))) const char* lds_cptr;
typedef short v4i16_t __attribute__((ext_vector_type(4)));
__device__ __forceinline__ void kload8(bf16x8*kf,lds_cptr kp){
  kf[0]=*(const __attribute__((address_space(3))) bf16x8*)(kp);      kf[1]=*(const __attribute__((address_space(3))) bf16x8*)(kp+512);
  kf[2]=*(const __attribute__((address_space(3))) bf16x8*)(kp+2048); kf[3]=*(const __attribute__((address_space(3))) bf16x8*)(kp+2560);
  kf[4]=*(const __attribute__((address_space(3))) bf16x8*)(kp+4096); kf[5]=*(const __attribute__((address_space(3))) bf16x8*)(kp+4608);
  kf[6]=*(const __attribute__((address_space(3))) bf16x8*)(kp+6144); kf[7]=*(const __attribute__((address_space(3))) bf16x8*)(kp+6656);
}
__device__ __forceinline__ void kload2(bf16x8*kf,lds_cptr kp,int j){ kf[2*j]=*(const __attribute__((address_space(3))) bf16x8*)(kp+j*2048); kf[2*j+1]=*(const __attribute__((address_space(3))) bf16x8*)(kp+j*2048+512); }
__device__ __forceinline__ s16x4 vtr(lds_cptr p){ return __builtin_bit_cast(s16x4,__builtin_amdgcn_ds_read_tr16_b64_v4i16((__attribute__((address_space(3))) v4i16_t*)p)); }
__device__ __forceinline__ float rowmax(const f32x16&p0,const f32x16&p1){
  float a=max3f(p0[0],p0[1],p1[0]),b=max3f(p0[2],p0[3],p1[1]);a=max3f(a,p1[2],p1[3]);
  #pragma unroll
  for(int r=4;r<16;r+=4){a=max3f(a,p0[r],p0[r+1]);b=max3f(b,p0[r+2],p0[r+3]);a=max3f(a,p1[r],p1[r+1]);b=max3f(b,p1[r+2],p1[r+3]);}
  const float m=max2f(a,b);
  auto rr=__builtin_amdgcn_permlane32_swap(__float_as_uint(m),__float_as_uint(m),false,false);
  return max2f(__uint_as_float(rr[0]),__uint_as_float(rr[1]));
}
__device__ __forceinline__ void pv(f32x16*o,int vb,bf16x8 pa0,bf16x8 pa1,bf16x8 pa2,bf16x8 pa3){
  #pragma unroll
  for(int d0=0;d0<2;++d0){s16x4 lo[4],hi[4];
    #pragma unroll
    for(int ks=0;ks<4;++ks){
      asm volatile("ds_read_b64_tr_b16 %0,%1 offset:%c2":"=&v"(lo[ks]):"v"(vb),"i"(d0*4096+ks*1024):"memory");
      asm volatile("ds_read_b64_tr_b16 %0,%1 offset:%c2":"=&v"(hi[ks]):"v"(vb),"i"(d0*4096+ks*1024+512):"memory");}
    asm volatile("s_waitcnt lgkmcnt(0)":::"memory");SBAR();
    #define PK(k) (bf16x8){lo[k][0],lo[k][1],lo[k][2],lo[k][3],hi[k][0],hi[k][1],hi[k][2],hi[k][3]}
    o[d0]=__builtin_amdgcn_mfma_f32_32x32x16_bf16(pa0,PK(0),o[d0],0,0,0);
    o[d0]=__builtin_amdgcn_mfma_f32_32x32x16_bf16(pa1,PK(1),o[d0],0,0,0);
    o[d0]=__builtin_amdgcn_mfma_f32_32x32x16_bf16(pa2,PK(2),o[d0],0,0,0);
    o[d0]=__builtin_amdgcn_mfma_f32_32x32x16_bf16(pa3,PK(3),o[d0],0,0,0);
    #undef PK
  }
}

#ifndef ATTN_STORE16
#define ATTN_STORE16(p,v) (*(u32x4*)(p)=(v))
#endif
template<int THRL> __device__ __forceinline__ void attn_unit(int b,int h,int qb,int t_first,const float*LPh,const FLDS double*dbase,const bf16*Q,const bf16*__restrict__ K,const bf16*__restrict__ V,bf16*O,FLDS char*shm,int tid_in){
  int tid_=tid_in; asm volatile("":"+v"(tid_)); const int tid=tid_,lane=tid&63,r32=lane&31,hi=lane>>5; const int wid=__builtin_amdgcn_readfirstlane(tid>>6);
  const long rowbase=(long)b*SEQ; const int q0=qb*QB;
  const bf16*Qw=Q+(rowbase+q0+wid*QBLK)*DM+h*D;
  const bf16*Kh=K+(rowbase+(long)t_first*KVBLK)*DM+h*D,*Vh=V+(rowbase+(long)t_first*KVBLK)*DM+h*D;
  const unsigned lds0=(unsigned)(uintptr_t)shm;
  FLDS float*wsf=(FLDS float*)(shm+LDS_WS)+wid*64;
  const bf16*ksrc=Kh+(long)lane*DM+wid*8;
  const bf16*vsrc=Vh+(long)(16*(wid&3)+(lane>>2))*DM+(wid>>2)*32+(lane&3)*8;
  const unsigned kdst=lds0+LDS_K+wid*1024, vdst=lds0+LDS_V+wid*1024;
  #define DMA_K(t,slot) glds16(ksrc+(long)(t)*KVBLK*DM,(unsigned)__builtin_amdgcn_readfirstlane(kdst+(slot)))
  #define DMA_V(t,slot) glds16(vsrc+(long)(t)*KVBLK*DM,(unsigned)__builtin_amdgcn_readfirstlane(vdst+(slot)))
  const int vb0=(int)(lds0+LDS_V)+((lane>>4)&1)*32+(lane&3)*8+(4*hi+((lane&15)>>2))*64;
  const FLDS char*Kbase=shm+LDS_K; bf16x8 kf[8];
  const lds_cptr shm3=(lds_cptr)shm; const lds_cptr kp0=shm3+LDS_K+hi*1024+r32*16; const lds_cptr vp0=shm3+LDS_V+((lane>>4)&1)*32+(lane&3)*8+(4*hi+((lane&15)>>2))*64;
  const int NT=(q0+QB)/KVBLK-t_first;
  DMA_K(0,0);DMA_V(0,0);DMA_K(1,SLOTB);
  { const double dref=dbase[(q0+QB-1)>>6]+(double)LPh[q0+QB-1]; FLDS unsigned*bt=(FLDS unsigned*)(shm+LDS_BT);
    const float*Lt=LPh+(long)t_first*KVBLK; const int NE=NT*KVBLK;
    for(int i0=0;i0<NE;i0+=8*NW*64){ double dv[8];
      _Pragma("unroll") for(int k=0;k<8;++k){ const int i=i0+k*NW*64+tid; dv[k]=(i<NE)?dbase[t_first+(i>>6)]+(double)Lt[i]:dref; }
      _Pragma("unroll") for(int k=0;k<8;++k){ const int i=i0+k*NW*64+tid; const float bv=(float)(dref-dv[k])*1.4426950408889634f; const float bh=__uint_as_float(cvtpk_s(bv,0.f)<<16); if(i<NE)bt[i]=cvtpk_s(bh,bv-bh); } } }
  const FLDS unsigned*btl=(const FLDS unsigned*)(shm+LDS_BT)+r32;
  const short AY1=hi?(short)0:(short)0x3F80; const unsigned BQX=hi?0u:0x3F803F80u;
  #define ABK(t,o) __builtin_bit_cast(s16x4b,(unsigned long long)btl[(t)*KVBLK+(o)]|((unsigned long long)(unsigned short)AY1<<48))
  #define BQV() __builtin_bit_cast(s16x4b,(unsigned long long)BQX|((unsigned long long)(hi?0u:(__float_as_uint(-mhat)&0xffff0000u))<<32))

  bf16x8 qr[4];
  #pragma unroll
  for(int d0=0;d0<4;++d0)qr[d0]=*reinterpret_cast<const bf16x8*>(&Qw[(long)r32*DM+d0*16+hi*8]);
  float mhat=0.f,l_reg=0.f;f32x16 o[2];o[0]=f32x16{};o[1]=f32x16{};s16x4b bq=BQV();
  const f32x16 zz=f32x16{};
  const int qrel=wid*QBLK+r32;
  #define CMASK(P0,P1,t) do{int jb_=(t)-(NT-4); if(jb_>=0)cmask(P0,P1,jb_,qrel,hi);}while(0)
  bool resc=false;
  #define START(P0,P1) do{ const float rm=rowmax(P0,P1); resc=false; \
    { const float mn_=__uint_as_float(cvtpk_s(mhat+rm,0.f)<<16); const float dl=mn_-mhat; mhat=mn_; \
      _Pragma("unroll") for(int r=0;r<16;++r){P0[r]=fsub_s(P0[r],dl);P1[r]=fsub_s(P1[r],dl);} \
      bq=BQV(); asm volatile("":"+v"(bq)); } \
    _Pragma("unroll") for(int r=0;r<16;++r)P0[r]=__builtin_amdgcn_exp2f(P0[r]); }while(0)
  #define RESC() do{ if(resc){ asm volatile("s_waitcnt lgkmcnt(0)":::"memory"); \
      _Pragma("unroll") for(int d_=0;d_<2;++d_) _Pragma("unroll") for(int r=0;r<16;++r)o[d_][r]*=wsf[crow(r,hi)]; } }while(0)
  f32x16 pA0,pA1,pB0,pB1;
  int sl_prev=0,sl_cur=0,sl_next=SLOTB;
  #define ROT() do{sl_prev=sl_cur;sl_cur=sl_next;sl_next=(sl_next==(NSLOT-1)*SLOTB)?0:sl_next+SLOTB;}while(0)
  DMA_K(2,2*SLOTB);
  WAIT_BAR(3);
  qkt(pA0,pA1,Kbase,qr,ABK(0,0),ABK(0,32),bq,r32,hi);asm volatile("s_nop 15\n\ts_nop 7":"+v"(pA0),"+v"(pA1));CMASK(pA0,pA1,0);
  START(pA0,pA1);
  _Pragma("unroll") for(int r=0;r<16;++r)pA1[r]=__builtin_amdgcn_exp2f(pA1[r]);
  WAIT_BAR(0);
  DMA_K(3,0);DMA_V(1,SLOTB);
  ROT();
  kload8(kf,kp0+sl_cur);
  WAIT_BAR(2);
  s16x4 vlo[8],vhi[8]; u32x4 pw0,pw1,pw2,pw3;
  #define PKW(P,B) cvtpk_s(P[B],P[B+1])
  #define PAF(k) __builtin_bit_cast(bf16x8,pw##k)
  #define VFR(i) (bf16x8){vlo[i][0],vlo[i][1],vlo[i][2],vlo[i][3],vhi[i][0],vhi[i][1],vhi[i][2],vhi[i][3]}
  #define PIN(x) asm volatile("":"+v"(x))
  #define MX3(a,b,c) __builtin_fmaxf(__builtin_fmaxf((a),(b)),(c))
  #define GAPA(MF,A0,A1,A2,A3,W0,W1,PW) do{ MF; sacc+=A0; sacc+=A1; sacc+=A2; sacc+=A3; PIN(sacc); W0; W1; PIN(PW); SBAR(); }while(0)
  #define EX(v) __builtin_amdgcn_exp2f(v)
  #define GAPB(MF,X,B) do{ MF; X[B]=EX(X[B]); X[B+1]=EX(X[B+1]); X[B+2]=EX(X[B+2]); X[B+3]=EX(X[B+3]); PIN(X); SBAR(); }while(0)
  #define VRD(i) do{ vlo[i]=vtr(vp_+(((i)>>2)*4096+((i)&3)*1024)); vhi[i]=vtr(vp_+(((i)>>2)*4096+((i)&3)*1024+512)); }while(0)
  #define KRD(G,j) do{ if(G){ kload2(kf,kp0+sl_next,j); SBAR(); } }while(0)
  #define STEP(C0,C1,P0,P1,t,GK,GV,GL) do{ SBAR(); \
    const s16x4b ab0_=ABK(t,0),ab1_=ABK(t,32); \
    const lds_cptr vp_=vp0+sl_prev; \
    VRD(0); SBAR(); float sacc=(P0[0]+P0[1]); \
    GAPA(C0=__builtin_amdgcn_mfma_f32_32x32x16_bf16(kf[0],qr[0],zz,0,0,0), P0[2],P0[3],P0[4],P0[5],     pw0[0]=PKW(P0,0), pw0[1]=PKW(P0,2), pw0); \
    VRD(4); SBAR(); GAPA(C1=__builtin_amdgcn_mfma_f32_32x32x16_bf16(kf[1],qr[0],zz,0,0,0), P0[6],P0[7],P0[8],P0[9],     pw0[2]=PKW(P0,4), pw0[3]=PKW(P0,6), pw0); \
    VRD(1); SBAR(); GAPA(C0=__builtin_amdgcn_mfma_f32_32x32x16_bf16(kf[2],qr[1],C0,0,0,0),   P0[10],P0[11],P0[12],P0[13], pw1[0]=PKW(P0,8), pw1[1]=PKW(P0,10), pw1); \
    VRD(5); SBAR(); GAPA(C1=__builtin_amdgcn_mfma_f32_32x32x16_bf16(kf[3],qr[1],C1,0,0,0),   P0[14],P0[15],P1[0],P1[1],   pw1[2]=PKW(P0,12),pw1[3]=PKW(P0,14), pw1); \
    VRD(2); SBAR(); GAPA(C0=__builtin_amdgcn_mfma_f32_32x32x16_bf16(kf[4],qr[2],C0,0,0,0),   P1[2],P1[3],P1[4],P1[5],     pw2[0]=PKW(P1,0), pw2[1]=PKW(P1,2), pw2); \
    VRD(6); SBAR(); GAPA(C1=__builtin_amdgcn_mfma_f32_32x32x16_bf16(kf[5],qr[2],C1,0,0,0),   P1[6],P1[7],P1[8],P1[9],     pw2[2]=PKW(P1,4), pw2[3]=PKW(P1,6), pw2); \
    VRD(3); SBAR(); GAPA(C0=__builtin_amdgcn_mfma_f32_32x32x16_bf16(kf[6],qr[3],C0,0,0,0),   P1[10],P1[11],P1[12],P1[13], pw3[0]=PKW(P1,8), pw3[1]=PKW(P1,10), pw3); \
    VRD(7); SBAR(); GAPA(C1=__builtin_amdgcn_mfma_f32_32x32x16_bf16(kf[7],qr[3],C1,0,0,0),   P1[14],P1[15],0.f,0.f,       pw3[2]=PKW(P1,12),pw3[3]=PKW(P1,14), pw3); \
    BIASK(C0,ab0_,bq); BIASK(C1,ab1_,bq); \
    l_reg+=sacc; \
    if(GK){DMA_K((t)+3,sl_cur);} if(GV){DMA_V((t)+1,sl_next);} \
    CMASK(C0,C1,t); \
    { float a=MX3(C0[0],C0[1],C1[0]),b=MX3(C0[2],C0[3],C1[1]); a=MX3(a,C1[2],C1[3]); \
      _Pragma("unroll") for(int r=4;r<16;r+=4){a=MX3(a,C0[r],C0[r+1]);b=MX3(b,C0[r+2],C0[r+3]);a=MX3(a,C1[r],C1[r+1]);b=MX3(b,C1[r+2],C1[r+3]);} \
      float rm=__builtin_fmaxf(a,b); { auto rr=__builtin_amdgcn_permlane32_swap(__float_as_uint(rm),__float_as_uint(rm),false,false); rm=__builtin_fmaxf(__uint_as_float(rr[0]),__uint_as_float(rr[1])); } \
      resc=false; \
      if(__builtin_expect(__any(rm>(float)THRL),0)){ const float mn_=__uint_as_float(cvtpk_s(mhat+__builtin_fmaxf(rm,0.f),0.f)<<16); const float dl=mn_-mhat; mhat=mn_; \
        _Pragma("unroll") for(int r=0;r<16;++r){C0[r]-=dl;C1[r]-=dl;} \
        bq=BQV(); asm volatile("":"+v"(bq)); \
        const float f=__builtin_amdgcn_exp2f(-dl); l_reg*=f; if(hi==0)wsf[r32]=f; resc=true; } } \
    SBAR(); \
    GAPB(o[0]=__builtin_amdgcn_mfma_f32_32x32x16_bf16(PAF(0),VFR(0),o[0],0,0,0), C0,0); \
    GAPB(o[1]=__builtin_amdgcn_mfma_f32_32x32x16_bf16(PAF(0),VFR(4),o[1],0,0,0), C0,4); \
    KRD(GL,0); GAPB(o[0]=__builtin_amdgcn_mfma_f32_32x32x16_bf16(PAF(1),VFR(1),o[0],0,0,0), C0,8); \
    KRD(GL,1); GAPB(o[1]=__builtin_amdgcn_mfma_f32_32x32x16_bf16(PAF(1),VFR(5),o[1],0,0,0), C0,12); \
    KRD(GL,2); GAPB(o[0]=__builtin_amdgcn_mfma_f32_32x32x16_bf16(PAF(2),VFR(2),o[0],0,0,0), C1,0); \
    KRD(GL,3); GAPB(o[1]=__builtin_amdgcn_mfma_f32_32x32x16_bf16(PAF(2),VFR(6),o[1],0,0,0), C1,4); \
    GAPB(o[0]=__builtin_amdgcn_mfma_f32_32x32x16_bf16(PAF(3),VFR(3),o[0],0,0,0), C1,8); \
    GAPB(o[1]=__builtin_amdgcn_mfma_f32_32x32x16_bf16(PAF(3),VFR(7),o[1],0,0,0), C1,12); \
    }while(0)
  int t=1;
  #undef CMASK
  #define CMASK(P0,P1,t) do{}while(0)
  for(;t+5<NT;t+=2){
    STEP(pB0,pB1,pA0,pA1,t,true,true,true);     WAIT_BAR(2); RESC(); ROT();
    STEP(pA0,pA1,pB0,pB1,t+1,true,true,true);   WAIT_BAR(2); RESC(); ROT();
  }
  #undef CMASK
  #define CMASK(P0,P1,t) do{int jb_=(t)-(NT-4); if(jb_>=0)cmask(P0,P1,jb_,qrel,hi);}while(0)
  #define ENDW(tt) do{ if((tt)+3<NT){WAIT_BAR(2);} else if((tt)+2<NT){WAIT_BAR(1);} else {WAIT_BAR(0);} }while(0)
  for(;t+1<NT;t+=2){
    STEP(pB0,pB1,pA0,pA1,t,(t+3<NT),(t+1<NT),(t+1<NT));       ENDW(t);   RESC(); ROT();
    STEP(pA0,pA1,pB0,pB1,t+1,(t+4<NT),(t+2<NT),(t+2<NT));     ENDW(t+1); RESC(); ROT();
  }
  STEP(pB0,pB1,pA0,pA1,NT-1,false,false,false); RESC();
  { float sacc=pB0[0]+pB0[1]; _Pragma("unroll") for(int r=2;r<16;++r)sacc+=pB0[r]; _Pragma("unroll") for(int r=0;r<16;++r)sacc+=pB1[r]; l_reg+=sacc;
    pw0=(u32x4){PKW(pB0,0),PKW(pB0,2),PKW(pB0,4),PKW(pB0,6)};pw1=(u32x4){PKW(pB0,8),PKW(pB0,10),PKW(pB0,12),PKW(pB0,14)};pw2=(u32x4){PKW(pB1,0),PKW(pB1,2),PKW(pB1,4),PKW(pB1,6)};pw3=(u32x4){PKW(pB1,8),PKW(pB1,10),PKW(pB1,12),PKW(pB1,14)};
    SBAR(); pv(o,vb0+sl_cur,PAF(0),PAF(1),PAF(2),PAF(3)); }
  #undef PKW
  #undef PAF
  #undef VFR
  #undef PIN
  #undef MX3
  #undef GAPA
  #undef GAPB
  #undef EX
  #undef VRD
  #undef KRD
  #undef STEP
  #undef ENDW
  {auto rr=__builtin_amdgcn_permlane32_swap(__float_as_uint(l_reg),__float_as_uint(l_reg),false,false);l_reg=__uint_as_float(rr[0])+__uint_as_float(rr[1]);}
  if(hi==0)wsf[32+r32]=l_reg;asm volatile("s_waitcnt lgkmcnt(0)":::"memory");
  float rli[16];
  #pragma unroll
  for(int r=0;r<16;++r)rli[r]=__builtin_amdgcn_rcpf(wsf[32+crow(r,hi)]);
  bf16*Ow=O+(rowbase+q0+wid*QBLK)*DM+h*D;
  asm volatile("s_waitcnt lgkmcnt(0)\n\ts_barrier":::"memory");
  { FLDS unsigned short*stg=(FLDS unsigned short*)(shm+LDS_OST)+wid*2048;
    #pragma unroll
    for(int r=0;r<16;++r){const int orow=crow(r,hi);
      #pragma unroll
      for(int d0=0;d0<2;++d0)stg[orow*64+d0*32+r32]=(unsigned short)(cvtpk_s(o[d0][r]*rli[r],0.f)&0xffffu);}
    asm volatile("s_waitcnt lgkmcnt(0)":::"memory");
    #pragma unroll
    for(int i=0;i<4;++i){const int row=i*8+(lane>>3),ch=lane&7; const u32x4 v=*(const FLDS u32x4*)(stg+row*64+ch*8); ATTN_STORE16(Ow+(long)row*DM+ch*8,v);} }
  asm volatile("s_waitcnt lgkmcnt(0)\n\ts_barrier":::"memory");
  #undef DMA_K
  #undef DMA_V
  #undef CMASK
  #undef ABK
  #undef BQV
  #undef START
  #undef RESC
  #undef ROT
}
template<int THRL> __device__ __forceinline__ void band_unit(int h,int qb,const float*relg,const bf16*Q,const bf16*__restrict__ K,const bf16*__restrict__ V,bf16*O,FLDS char*shm,int tid_in){
  int tid_=tid_in; asm volatile("":"+v"(tid_)); const int tid=tid_,lane=tid&63,r32=lane&31,hi=lane>>5; const int wid=__builtin_amdgcn_readfirstlane(tid>>6);
  const long rowbase=0; const int q0=qb*QB; const int t0b=(4*qb-8>0)?4*qb-8:0;
  const bf16*Qw=Q+(rowbase+q0+wid*QBLK)*DM+h*D;
  const bf16*Kh=K+(rowbase+(long)t0b*KVBLK)*DM+h*D,*Vh=V+(rowbase+(long)t0b*KVBLK)*DM+h*D;
  const unsigned lds0=(unsigned)(uintptr_t)shm;
  FLDS float*wsf=(FLDS float*)(shm+LDS_WS)+wid*64;
  const bf16*ksrc=Kh+(long)lane*DM+wid*8;
  const bf16*vsrc=Vh+(long)(16*(wid&3)+(lane>>2))*DM+(wid>>2)*32+(lane&3)*8;
  const unsigned kdst=lds0+LDS_K+wid*1024, vdst=lds0+LDS_V+wid*1024;
  #define DMA_K(t,slot) glds16(ksrc+(long)(t)*KVBLK*DM,(unsigned)__builtin_amdgcn_readfirstlane(kdst+(slot)))
  #define DMA_V(t,slot) glds16(vsrc+(long)(t)*KVBLK*DM,(unsigned)__builtin_amdgcn_readfirstlane(vdst+(slot)))
  const int vb0=(int)(lds0+LDS_V)+((lane>>4)&1)*32+(lane&3)*8+(4*hi+((lane&15)>>2))*64;
  const FLDS char*Kbase=shm+LDS_K; bf16x8 kf[8];
  const lds_cptr shm3=(lds_cptr)shm; const lds_cptr kp0=shm3+LDS_K+hi*1024+r32*16; const lds_cptr vp0=shm3+LDS_V+((lane>>4)&1)*32+(lane&3)*8+(4*hi+((lane&15)>>2))*64;
  const int NT=(q0+QB)/KVBLK-t0b;
  DMA_K(0,0);DMA_V(0,0);DMA_K(1,SLOTB);
  { FLDS float*tw=(FLDS float*)(shm+LDS_BT); for(int i=tid;i<257;i+=NW*64)tw[i]=relg[i]*1.4426950408889634f; }
  const FLDS float*tab=(const FLDS float*)(shm+LDS_BT);
  const int cqr=(NT-4)+(wid>>1);
  const float tbf=relg[256]*1.4426950408889634f; const float tbfh=__uint_as_float(cvtpk_s(tbf,0.f)<<16); const unsigned TBFAR=cvtpk_s(tbfh,tbf-tbfh), TBMASK=cvtpk_s(-29952.f,-48.f);
  const s16x4b ABC=__builtin_bit_cast(s16x4b,hi?0ull:(0x3F803F80ull|(0x3F80ull<<48)));
  #define TBX(t) ((cqr-(t)<0||cqr-(t)>8)?TBMASK:((cqr-(t)>=3)?TBFAR:0u))
  #define BQV(t) __builtin_bit_cast(s16x4b,(unsigned long long)TBX(t)|((unsigned long long)(__float_as_uint(-mhat)&0xffff0000u)<<32))
  #define ABK(t,o) ABC

  bf16x8 qr[4];
  #pragma unroll
  for(int d0=0;d0<4;++d0)qr[d0]=*reinterpret_cast<const bf16x8*>(&Qw[(long)r32*DM+d0*16+hi*8]);
  float mhat=0.f,l_reg=0.f;f32x16 o[2];o[0]=f32x16{};o[1]=f32x16{};s16x4b bq=BQV(0);
  const f32x16 zz=f32x16{};
  const int qrel=wid*QBLK+r32;
  #define CMASK(P0,P1,t) do{ const int dc_=cqr-(t); if(dc_>=0&&dc_<=2){ const int dq_=64*dc_+32*(wid&1)+r32; _Pragma("unroll") for(int r=0;r<16;++r){ const int d_=dq_-crow(r,hi); const int i0_=d_>128?128:d_, i1_=(d_-32<-128)?-128:((d_-32>128)?128:d_-32); P0[r]+=tab[i0_+128]; P1[r]+=tab[i1_+128]; } } }while(0)
  bool resc=false;
  #define START(P0,P1) do{ const float rm=rowmax(P0,P1); resc=false; \
    { const float mn_=__uint_as_float(cvtpk_s(mhat+rm,0.f)<<16); const float dl=mn_-mhat; mhat=mn_; \
      _Pragma("unroll") for(int r=0;r<16;++r){P0[r]=fsub_s(P0[r],dl);P1[r]=fsub_s(P1[r],dl);} \
      bq=BQV(0); asm volatile("":"+v"(bq)); } \
    _Pragma("unroll") for(int r=0;r<16;++r)P0[r]=__builtin_amdgcn_exp2f(P0[r]); }while(0)
  #define RESC() do{ if(resc){ asm volatile("s_waitcnt lgkmcnt(0)":::"memory"); \
      _Pragma("unroll") for(int d_=0;d_<2;++d_) _Pragma("unroll") for(int r=0;r<16;++r)o[d_][r]*=wsf[crow(r,hi)]; } }while(0)
  f32x16 pA0,pA1,pB0,pB1;
  int sl_prev=0,sl_cur=0,sl_next=SLOTB;
  #define ROT() do{sl_prev=sl_cur;sl_cur=sl_next;sl_next=(sl_next==(NSLOT-1)*SLOTB)?0:sl_next+SLOTB;}while(0)
  DMA_K(2,2*SLOTB);
  WAIT_BAR(3);
  qkt(pA0,pA1,Kbase,qr,ABK(0,0),ABK(0,32),bq,r32,hi);asm volatile("s_nop 15\n\ts_nop 7":"+v"(pA0),"+v"(pA1));CMASK(pA0,pA1,0);
  START(pA0,pA1);
  _Pragma("unroll") for(int r=0;r<16;++r)pA1[r]=__builtin_amdgcn_exp2f(pA1[r]);
  WAIT_BAR(0);
  DMA_K(3,0);DMA_V(1,SLOTB);
  ROT();
  kload8(kf,kp0+sl_cur);
  WAIT_BAR(2);
  s16x4 vlo[8],vhi[8]; u32x4 pw0,pw1,pw2,pw3;
  #define PKW(P,B) cvtpk_s(P[B],P[B+1])
  #define PAF(k) __builtin_bit_cast(bf16x8,pw##k)
  #define VFR(i) (bf16x8){vlo[i][0],vlo[i][1],vlo[i][2],vlo[i][3],vhi[i][0],vhi[i][1],vhi[i][2],vhi[i][3]}
  #define PIN(x) asm volatile("":"+v"(x))
  #define MX3(a,b,c) __builtin_fmaxf(__builtin_fmaxf((a),(b)),(c))
  #define GAPA(MF,A0,A1,A2,A3,W0,W1,PW) do{ MF; sacc+=A0; sacc+=A1; sacc+=A2; sacc+=A3; PIN(sacc); W0; W1; PIN(PW); SBAR(); }while(0)
  #define EX(v) __builtin_amdgcn_exp2f(v)
  #define GAPB(MF,X,B) do{ MF; X[B]=EX(X[B]); X[B+1]=EX(X[B+1]); X[B+2]=EX(X[B+2]); X[B+3]=EX(X[B+3]); PIN(X); SBAR(); }while(0)
  #define VRD(i) do{ vlo[i]=vtr(vp_+(((i)>>2)*4096+((i)&3)*1024)); vhi[i]=vtr(vp_+(((i)>>2)*4096+((i)&3)*1024+512)); }while(0)
  #define KRD(G,j) do{ if(G){ kload2(kf,kp0+sl_next,j); SBAR(); } }while(0)
  #define STEP(C0,C1,P0,P1,t,GK,GV,GL) do{ SBAR(); \
    const s16x4b ab0_=ABC,ab1_=ABC; bq=BQV(t); \
    const lds_cptr vp_=vp0+sl_prev; \
    VRD(0); SBAR(); float sacc=(P0[0]+P0[1]); \
    GAPA(C0=__builtin_amdgcn_mfma_f32_32x32x16_bf16(kf[0],qr[0],zz,0,0,0), P0[2],P0[3],P0[4],P0[5],     pw0[0]=PKW(P0,0), pw0[1]=PKW(P0,2), pw0); \
    VRD(4); SBAR(); GAPA(C1=__builtin_amdgcn_mfma_f32_32x32x16_bf16(kf[1],qr[0],zz,0,0,0), P0[6],P0[7],P0[8],P0[9],     pw0[2]=PKW(P0,4), pw0[3]=PKW(P0,6), pw0); \
    VRD(1); SBAR(); GAPA(C0=__builtin_amdgcn_mfma_f32_32x32x16_bf16(kf[2],qr[1],C0,0,0,0),   P0[10],P0[11],P0[12],P0[13], pw1[0]=PKW(P0,8), pw1[1]=PKW(P0,10), pw1); \
    VRD(5); SBAR(); GAPA(C1=__builtin_amdgcn_mfma_f32_32x32x16_bf16(kf[3],qr[1],C1,0,0,0),   P0[14],P0[15],P1[0],P1[1],   pw1[2]=PKW(P0,12),pw1[3]=PKW(P0,14), pw1); \
    VRD(2); SBAR(); GAPA(C0=__builtin_amdgcn_mfma_f32_32x32x16_bf16(kf[4],qr[2],C0,0,0,0),   P1[2],P1[3],P1[4],P1[5],     pw2[0]=PKW(P1,0), pw2[1]=PKW(P1,2), pw2); \
    VRD(6); SBAR(); GAPA(C1=__builtin_amdgcn_mfma_f32_32x32x16_bf16(kf[5],qr[2],C1,0,0,0),   P1[6],P1[7],P1[8],P1[9],     pw2[2]=PKW(P1,4), pw2[3]=PKW(P1,6), pw2); \
    VRD(3); SBAR(); GAPA(C0=__builtin_amdgcn_mfma_f32_32x32x16_bf16(kf[6],qr[3],C0,0,0,0),   P1[10],P1[11],P1[12],P1[13], pw3[0]=PKW(P1,8), pw3[1]=PKW(P1,10), pw3); \
    VRD(7); SBAR(); GAPA(C1=__builtin_amdgcn_mfma_f32_32x32x16_bf16(kf[7],qr[3],C1,0,0,0),   P1[14],P1[15],0.f,0.f,       pw3[2]=PKW(P1,12),pw3[3]=PKW(P1,14), pw3); \
    BIASK(C0,ab0_,bq); BIASK(C1,ab1_,bq); \
    l_reg+=sacc; \
    if(GK){DMA_K((t)+3,sl_cur);} if(GV){DMA_V((t)+1,sl_next);} \
    CMASK(C0,C1,t); \
    { float a=MX3(C0[0],C0[1],C1[0]),b=MX3(C0[2],C0[3],C1[1]); a=MX3(a,C1[2],C1[3]); \
      _Pragma("unroll") for(int r=4;r<16;r+=4){a=MX3(a,C0[r],C0[r+1]);b=MX3(b,C0[r+2],C0[r+3]);a=MX3(a,C1[r],C1[r+1]);b=MX3(b,C1[r+2],C1[r+3]);} \
      float rm=__builtin_fmaxf(a,b); { auto rr=__builtin_amdgcn_permlane32_swap(__float_as_uint(rm),__float_as_uint(rm),false,false); rm=__builtin_fmaxf(__uint_as_float(rr[0]),__uint_as_float(rr[1])); } \
      resc=false; \
      if(__builtin_expect(__any(rm>(float)THRL),0)){ const float mn_=__uint_as_float(cvtpk_s(mhat+__builtin_fmaxf(rm,0.f),0.f)<<16); const float dl=mn_-mhat; mhat=mn_; \
        _Pragma("unroll") for(int r=0;r<16;++r){C0[r]-=dl;C1[r]-=dl;} \
        bq=BQV(t); asm volatile("":"+v"(bq)); \
        const float f=__builtin_amdgcn_exp2f(-dl); l_reg*=f; if(hi==0)wsf[r32]=f; resc=true; } } \
    SBAR(); \
    GAPB(o[0]=__builtin_amdgcn_mfma_f32_32x32x16_bf16(PAF(0),VFR(0),o[0],0,0,0), C0,0); \
    GAPB(o[1]=__builtin_amdgcn_mfma_f32_32x32x16_bf16(PAF(0),VFR(4),o[1],0,0,0), C0,4); \
    KRD(GL,0); GAPB(o[0]=__builtin_amdgcn_mfma_f32_32x32x16_bf16(PAF(1),VFR(1),o[0],0,0,0), C0,8); \
    KRD(GL,1); GAPB(o[1]=__builtin_amdgcn_mfma_f32_32x32x16_bf16(PAF(1),VFR(5),o[1],0,0,0), C0,12); \
    KRD(GL,2); GAPB(o[0]=__builtin_amdgcn_mfma_f32_32x32x16_bf16(PAF(2),VFR(2),o[0],0,0,0), C1,0); \
    KRD(GL,3); GAPB(o[1]=__builtin_amdgcn_mfma_f32_32x32x16_bf16(PAF(2),VFR(6),o[1],0,0,0), C1,4); \
    GAPB(o[0]=__builtin_amdgcn_mfma_f32_32x32x16_bf16(PAF(3),VFR(3),o[0],0,0,0), C1,8); \
    GAPB(o[1]=__builtin_amdgcn_mfma_f32_32x32x16_bf16(PAF(3),VFR(7),o[1],0,0,0), C1,12); \
    }while(0)
  int t=1;
  #undef CMASK
  #define CMASK(P0,P1,t) do{}while(0)
  for(;t+7<NT;t+=2){
    STEP(pB0,pB1,pA0,pA1,t,true,true,true);     WAIT_BAR(2); RESC(); ROT();
    STEP(pA0,pA1,pB0,pB1,t+1,true,true,true);   WAIT_BAR(2); RESC(); ROT();
  }
  #undef CMASK
  #define CMASK(P0,P1,t) do{ const int dc_=cqr-(t); if(dc_>=0&&dc_<=2){ const int dq_=64*dc_+32*(wid&1)+r32; _Pragma("unroll") for(int r=0;r<16;++r){ const int d_=dq_-crow(r,hi); const int i0_=d_>128?128:d_, i1_=(d_-32<-128)?-128:((d_-32>128)?128:d_-32); P0[r]+=tab[i0_+128]; P1[r]+=tab[i1_+128]; } } }while(0)
  #define ENDW(tt) do{ if((tt)+3<NT){WAIT_BAR(2);} else if((tt)+2<NT){WAIT_BAR(1);} else {WAIT_BAR(0);} }while(0)
  for(;t+1<NT;t+=2){
    STEP(pB0,pB1,pA0,pA1,t,(t+3<NT),(t+1<NT),(t+1<NT));       ENDW(t);   RESC(); ROT();
    STEP(pA0,pA1,pB0,pB1,t+1,(t+4<NT),(t+2<NT),(t+2<NT));     ENDW(t+1); RESC(); ROT();
  }
  STEP(pB0,pB1,pA0,pA1,NT-1,false,false,false); RESC();
  { float sacc=pB0[0]+pB0[1]; _Pragma("unroll") for(int r=2;r<16;++r)sacc+=pB0[r]; _Pragma("unroll") for(int r=0;r<16;++r)sacc+=pB1[r]; l_reg+=sacc;
    pw0=(u32x4){PKW(pB0,0),PKW(pB0,2),PKW(pB0,4),PKW(pB0,6)};pw1=(u32x4){PKW(pB0,8),PKW(pB0,10),PKW(pB0,12),PKW(pB0,14)};pw2=(u32x4){PKW(pB1,0),PKW(pB1,2),PKW(pB1,4),PKW(pB1,6)};pw3=(u32x4){PKW(pB1,8),PKW(pB1,10),PKW(pB1,12),PKW(pB1,14)};
    SBAR(); pv(o,vb0+sl_cur,PAF(0),PAF(1),PAF(2),PAF(3)); }
  #undef PKW
  #undef PAF
  #undef VFR
  #undef PIN
  #undef MX3
  #undef GAPA
  #undef GAPB
  #undef EX
  #undef VRD
  #undef KRD
  #undef STEP
  #undef ENDW
  {auto rr=__builtin_amdgcn_permlane32_swap(__float_as_uint(l_reg),__float_as_uint(l_reg),false,false);l_reg=__uint_as_float(rr[0])+__uint_as_float(rr[1]);}
  if(hi==0)wsf[32+r32]=l_reg;asm volatile("s_waitcnt lgkmcnt(0)":::"memory");
  float rli[16];
  #pragma unroll
  for(int r=0;r<16;++r)rli[r]=__builtin_amdgcn_rcpf(wsf[32+crow(r,hi)]);
  bf16*Ow=O+(rowbase+q0+wid*QBLK)*DM+h*D;
  asm volatile("s_waitcnt lgkmcnt(0)\n\ts_barrier":::"memory");
  { FLDS unsigned short*stg=(FLDS unsigned short*)(shm+LDS_OST)+wid*2048;
    #pragma unroll
    for(int r=0;r<16;++r){const int orow=crow(r,hi);
      #pragma unroll
      for(int d0=0;d0<2;++d0)stg[orow*64+d0*32+r32]=(unsigned short)(cvtpk_s(o[d0][r]*rli[r],0.f)&0xffffu);}
    asm volatile("s_waitcnt lgkmcnt(0)":::"memory");
    #pragma unroll
    for(int i=0;i<4;++i){const int row=i*8+(lane>>3),ch=lane&7; const u32x4 v=*(const FLDS u32x4*)(stg+row*64+ch*8); ATTN_STORE16(Ow+(long)row*DM+ch*8,v);} }
  asm volatile("s_waitcnt lgkmcnt(0)\n\ts_barrier":::"memory");
  #undef DMA_K
  #undef DMA_V
  #undef CMASK
  #undef ABK
  #undef BQV
  #undef TBX
  #undef START
  #undef RESC
  #undef ROT
}
constexpr int ATTN_LDS_BYTES=LDS_BYTES;
#undef SBAR
#undef WAIT_BAR
#undef BIASK
#undef FLDS
}

#ifndef N_LAUNCH_PER_PHASE
#define N_LAUNCH_PER_PHASE 0
#endif
constexpr int NWAVES = 8;
constexpr size_t MiB = 1u << 20;
constexpr size_t WS_CTL = 0, CTL_ZERO_BYTES = 1 * MiB;
constexpr size_t WS_WIN = 2 * MiB;
constexpr size_t WIN_STRIDE = (size_t)3328 * 1024 * 2;
constexpr size_t WS_WOUT = WS_WIN + 4 * WIN_STRIDE;
constexpr size_t WS_WFF1 = WS_WOUT + 4 * (size_t)1024 * 1024 * 2;
constexpr size_t WS_WFF2 = WS_WFF1 + 4 * (size_t)4096 * 1024 * 2;
constexpr size_t WS_WG = WS_WFF2 + 4 * (size_t)4096 * 1024 * 2;
constexpr size_t WS_WPP = WS_WG + 4 * (size_t)1024 * 1024 * 2;
constexpr size_t WS_PB = WS_WPP + 4 * (size_t)1024 * 256 * 2;
constexpr size_t WS_HB0 = WS_PB + 4 * (size_t)MROWS * 256 * 2;
constexpr size_t WS_HB1 = WS_HB0 + (size_t)MROWS * DM * 2;
constexpr size_t WS_SSQ0 = WS_HB1 + (size_t)MROWS * DM * 2;
constexpr size_t WS_SSQ1 = WS_SSQ0 + (size_t)MROWS * 16 * 4;
constexpr size_t WS_PP = WS_SSQ1 + (size_t)MROWS * 16 * 4;
constexpr size_t WS_DP = WS_PP + (size_t)MROWS * DM * 2;
constexpr size_t WS_DS = WS_DP + (size_t)16 * SEQ * 8;
constexpr size_t WS_TT = WS_DS + (size_t)256 * (PAST + 16) * 8;
constexpr size_t WS_Q = ((WS_TT + 16 * 256 * 8 + MiB - 1) / MiB) * MiB;
constexpr size_t WS_K = WS_Q + (size_t)MROWS * DM * 2;
constexpr size_t WS_V = WS_K + (size_t)MROWS * DM * 2;
constexpr size_t WS_O = WS_V + (size_t)MROWS * DM * 2;
constexpr size_t WS_HID = WS_Q;
constexpr size_t WS_END = WS_HID + (size_t)MROWS * FF * 2;
constexpr size_t WS_DUMMY = 800 * MiB;
static_assert(WS_END < 768 * MiB && WS_K - WS_Q == (size_t)MROWS * DM * 2 && WS_V - WS_K == (size_t)MROWS * DM * 2, "workspace map");
constexpr int CW_BAR = 4096, CW_QUEUE = 16384;

constexpr int RING_OFF = 0, RING_BYTES = 131072;
constexpr int BTAB_OFF = att::ATT_LDS_BYTES, BTAB_STRIDE = 1040;
constexpr int MISC_OFF = 146944;
constexpr int LDS_BYTES = 147456;
static_assert(BTAB_OFF + 8 * BTAB_STRIDE <= MISC_OFF && att::ATT_LDS_BYTES <= MISC_OFF && fox::ATTN_LDS_BYTES <= MISC_OFF && RING_BYTES <= MISC_OFF && MISC_OFF + 128 <= LDS_BYTES, "LDS map");

#define GAS __attribute__((address_space(1)))
#define LAS __attribute__((address_space(3)))
typedef unsigned short bf16;
typedef unsigned v4u __attribute__((ext_vector_type(4)));
typedef float f32x4 __attribute__((ext_vector_type(4)));
#define LDS_WAIT() asm volatile("s_waitcnt lgkmcnt(0)" ::: "memory")
__device__ __forceinline__ unsigned f2bf(float f) { unsigned u = __builtin_bit_cast(unsigned, f); return (u + 0x7fffu + ((u >> 16) & 1u)) >> 16; }
__device__ __forceinline__ unsigned pk2(float lo, float hi) { return f2bf(lo) | (f2bf(hi) << 16); }
#define XB_TMO      128
#define XB_XCNT(j)  (256  + 64 * (j))
#define XB_XSUB(j)  (1280 + 64 * (j))
#define XB_XGEN(j)  (2304 + 64 * (j))
#define XB_TOP      3328
#define XB_TOPGEN   3392
#define XCD_BAR_WORDS 3456
#define XB_SPIN_CAP (1u << 18)

__device__ __forceinline__ unsigned xb_ld(unsigned* p)              { return __hip_atomic_load(p, __ATOMIC_RELAXED, __HIP_MEMORY_SCOPE_AGENT); }
__device__ __forceinline__ unsigned xb_add(unsigned* p, unsigned v) { return __hip_atomic_fetch_add(p, v, __ATOMIC_RELAXED, __HIP_MEMORY_SCOPE_AGENT); }
__device__ __forceinline__ unsigned xb_xcc_id() { return (unsigned)__builtin_amdgcn_s_getreg((3 << 11) | 20) & 0xFu; }
#define XB_SPIN(cond, bar) do { unsigned _sp = 0; while (cond) { __builtin_amdgcn_s_sleep(1); \
    if ((++_sp & 255u) == 0u) { if (xb_ld(&(bar)[XB_TMO])) break; if (_sp > XB_SPIN_CAP) { atomicAdd(&(bar)[XB_TMO], 1u); break; } } } } while (0)

struct XcdBarrier {
    unsigned* bar; unsigned x;
    volatile LAS unsigned* st;
};

__device__ __forceinline__ XcdBarrier xcd_barrier_post(unsigned* bar, volatile LAS unsigned* st) {
    XcdBarrier b; b.bar = bar; b.x = xb_xcc_id(); b.st = st;
    if (threadIdx.x == 0) (void)xb_add(&bar[XB_XCNT(b.x)], 1u);
    return b;
}
__device__ __forceinline__ void xcd_barrier_complete(unsigned* bar, unsigned x, unsigned& nloc, unsigned& nx) {
    const unsigned G = gridDim.x * gridDim.y * gridDim.z;
    unsigned sum, cnt, mine, sp = 0u;
    for (;;) {
        sum = 0u; cnt = 0u; mine = 0u;
#pragma unroll
        for (unsigned j = 0; j < 16; ++j) { const unsigned c = xb_ld(&bar[XB_XCNT(j)]); sum += c; cnt += (c > 0u) ? 1u : 0u; mine = (j == x) ? c : mine; }
        if (sum == G) break;
        __builtin_amdgcn_s_sleep(1);
        if ((++sp & 255u) == 0u) { if (xb_ld(&bar[XB_TMO])) break; if (sp > XB_SPIN_CAP) { atomicAdd(&bar[XB_TMO], 1u); break; } }
    }
    nloc = mine > 0u ? mine : 1u; nx = cnt > 0u ? cnt : 1u;
}

__device__ __forceinline__ void xcd_barrier(const XcdBarrier& b, int tid_in) {
    const int tid_b = tid_in;
    asm volatile("s_waitcnt vmcnt(0)" ::: "memory");
    __syncthreads();
    if (tid_b == 0) {
        unsigned* bar = b.bar;
        __builtin_amdgcn_s_waitcnt(0);
        unsigned nloc = b.st[0], nx = b.st[1];
        if (nloc == 0u) { xcd_barrier_complete(bar, b.x, nloc, nx); b.st[0] = nloc; b.st[1] = nx; }
        const unsigned old = xb_add(&bar[XB_XSUB(b.x)], 1u);
        const unsigned gen = old / nloc;
        if (old + 1u == (gen + 1u) * nloc) {
            __builtin_amdgcn_fence(__ATOMIC_RELEASE, "agent");
            asm volatile("s_waitcnt vmcnt(0)" ::: "memory");
            const unsigned og = xb_add(&bar[XB_TOP], 1u);
            const unsigned tg = og / nx;
            if (og + 1u == (tg + 1u) * nx) xb_add(&bar[XB_TOPGEN], 1u);
            else XB_SPIN(xb_ld(&bar[XB_TOPGEN]) == tg, bar);
            __builtin_amdgcn_fence(__ATOMIC_ACQUIRE, "agent");
            xb_add(&bar[XB_XGEN(b.x)], 1u);
            asm volatile("s_waitcnt vmcnt(0)" ::: "memory");
        } else {
            XB_SPIN(xb_ld(&bar[XB_XGEN(b.x)]) == gen, bar);
            __builtin_amdgcn_fence(__ATOMIC_ACQUIRE, "agent");
            asm volatile("s_waitcnt vmcnt(0)" ::: "memory");
        }
    }
    __syncthreads();
}

__device__ __forceinline__ float wave_sum(float v) {
#pragma unroll
    for (int o = 1; o < 64; o <<= 1) v += __shfl_xor(v, o);
    return v;
}
__device__ __forceinline__ int inproj_row(int c, int odd) {
    int t, hd; const int d = c & 63;
    if (odd) { t = c >> 10; hd = (c >> 6) & 15; }
    else { const int seg = c >> 9; t = seg % 3; hd = ((c >> 6) & 7) + 8 * (seg / 3); }
    const int ca = t * 1024 + hd * 64;
    return (ca & ~255) + 128 * (d >> 5) + 32 * (hd & 3);
}
__device__ __forceinline__ unsigned cvtpk_h(float lo, float hi) { unsigned r; asm volatile("v_cvt_pk_bf16_f32 %0, %1, %2" : "=v"(r) : "v"(lo), "v"(hi)); return r; }
__device__ __forceinline__ void transpose_item(const float* W, int ldw, int K, int k0, int n0, bf16* WT, int prow0, int prow1, const float* g, LAS float* scr, int lane) {
    const int n4 = lane & 15, kq = lane >> 4;
    f32x4 x[16];
#pragma unroll
    for (int i = 0; i < 16; ++i) x[i] = __builtin_nontemporal_load((const f32x4*)(W + (size_t)(k0 + kq + 4 * i) * ldw + n0 + 4 * n4));
#pragma unroll
    for (int i = 0; i < 16; ++i) { const int kk = kq + 4 * i; const float gs = g ? g[k0 + kk] : 1.0f;
#pragma unroll
        for (int e_ = 0; e_ < 4; ++e_) scr[(4 * n4 + e_) * 65 + kk] = x[i][e_] * gs; }
    LDS_WAIT(); asm volatile("" ::: "memory");
    const int c = lane & 7;
#pragma unroll
    for (int i = 0; i < 8; ++i) { const int n = (lane >> 3) + 8 * i; const LAS float* s = scr + n * 65 + 8 * c;
        v4u o; o.x = cvtpk_h(s[0], s[1]); o.y = cvtpk_h(s[2], s[3]); o.z = cvtpk_h(s[4], s[5]); o.w = cvtpk_h(s[6], s[7]);
        *(GAS v4u*)(WT + (size_t)((n < 32 ? prow0 + n : prow1 + n - 32)) * K + k0 + 8 * c) = o; }
    LDS_WAIT(); asm volatile("" ::: "memory");
}

__device__ __forceinline__ void transpose_item3(const float* W, int ldw, int K, int k0, int n0, bf16* WT, int prow0, int prow1, int prow2, int prow3, const float* g, LAS unsigned* scr, int lane) {
    const int n4 = lane & 31, kq = lane >> 5;
#pragma unroll
    for (int hh = 0; hh < 2; ++hh) {
        f32x4 xa[8], xb[8];
#pragma unroll
        for (int m = 0; m < 8; ++m) { const int ka = 4 * (8 * hh + m) + 2 * kq; const float* src = W + (size_t)(k0 + ka) * ldw + n0 + 4 * n4;
            xa[m] = __builtin_nontemporal_load((const f32x4*)src); xb[m] = __builtin_nontemporal_load((const f32x4*)(src + ldw)); }
#pragma unroll
        for (int m = 0; m < 8; ++m) { const int ka = 4 * (8 * hh + m) + 2 * kq; const float ga = g ? g[k0 + ka] : 1.0f, gb = g ? g[k0 + ka + 1] : 1.0f;
#pragma unroll
            for (int e_ = 0; e_ < 4; ++e_) scr[(4 * n4 + e_) * 33 + (ka >> 1)] = cvtpk_h(xa[m][e_] * ga, xb[m][e_] * gb); }
    }
    LDS_WAIT(); asm volatile("" ::: "memory");
    const int c = lane & 7;
#pragma unroll
    for (int i = 0; i < 16; ++i) { const int n = (lane >> 3) + 8 * i; const LAS unsigned* s = scr + n * 33 + 4 * c;
        v4u o; o.x = s[0]; o.y = s[1]; o.z = s[2]; o.w = s[3];
        const int pr = (i < 4) ? prow0 : (i < 8) ? prow1 : (i < 12) ? prow2 : prow3;
        *(GAS v4u*)(WT + (size_t)(pr + (n & 31)) * K + k0 + 8 * c) = o; }
    LDS_WAIT(); asm volatile("" ::: "memory");
}
#ifndef PRO_T3
#define PRO_T3 0
#endif
__device__ __forceinline__ void transpose_item2(const float* W, int ldw, int K, int k0, int n0, bf16* WT, int prow, const float* g, LAS float* scr, int lane) {
    const int n4 = lane & 7, kq = lane >> 3;
    f32x4 x[16];
#pragma unroll
    for (int i = 0; i < 16; ++i) x[i] = __builtin_nontemporal_load((const f32x4*)(W + (size_t)(k0 + kq + 8 * i) * ldw + n0 + 4 * n4));
#pragma unroll
    for (int i = 0; i < 16; ++i) { const int kk = kq + 8 * i; const float gs = g ? g[k0 + kk] : 1.0f;
#pragma unroll
        for (int e_ = 0; e_ < 4; ++e_) scr[(4 * n4 + e_) * 129 + kk] = x[i][e_] * gs; }
    LDS_WAIT(); asm volatile("" ::: "memory");
    const int c = lane & 15;
#pragma unroll
    for (int i = 0; i < 8; ++i) { const int n = (lane >> 4) + 4 * i; const LAS float* s = scr + n * 129 + 8 * c;
        v4u o; o.x = cvtpk_h(s[0], s[1]); o.y = cvtpk_h(s[2], s[3]); o.z = cvtpk_h(s[4], s[5]); o.w = cvtpk_h(s[6], s[7]);
        *(GAS v4u*)(WT + (size_t)(prow + n) * K + k0 + 8 * c) = o; }
    LDS_WAIT(); asm volatile("" ::: "memory");
}
#ifndef PRO_T2
#define PRO_T2 0
#endif
#ifndef PRO_ORDER
#define PRO_ORDER 1
#endif
#define PRO_DECODE(r, KB, NB, kb, nb) do { if (PRO_ORDER == 0) { kb = (r) / (NB); nb = (r) % (NB); } else if (PRO_ORDER == 1) { kb = (r) % (KB); nb = (r) / (KB); } \
    else { const int q_ = (r) >> 3, i_ = (r) & 7; kb = 4 * (q_ % ((KB) / 4)) + (i_ & 3); nb = 2 * (q_ / ((KB) / 4)) + (i_ >> 2); } } while (0)
#ifndef PRO_KFAST
#define PRO_KFAST 1
#endif
#ifndef PROBE_PRO_W
#define PROBE_PRO_W 1
#endif
#ifndef PROBE_PRO_S
#define PROBE_PRO_S 1
#endif
struct Args { const float* in[27]; float* out; unsigned char* ws; int ph_lo, ph_hi; };

template <class T> __device__ __forceinline__ T* as_global(T* p) { return (T*)(GAS T*)p; }
typedef const __attribute__((address_space(4))) Args* KArgs;
__device__ __forceinline__ void convert_inputs(KArgs Ak, LAS unsigned char* lds, int gw, int NGW, int wave, int lane_in, int Llo, int Lhi, bool do_x, bool do_band, int sel = -1  ) {
    int lane = lane_in; asm volatile("" : "+v"(lane));
    LAS float* scr = (LAS float*)(lds + wave * 16896);
#define AIN(i) as_global(Ak->in[i])
    unsigned char* ws = as_global(Ak->ws);
    constexpr int TD_ = PRO_T3 ? 2 : 1;
    constexpr int I_IN = 16 * 48 / TD_, I_OUT = 16 * 16 / TD_, I_F1 = 16 * 64 / TD_, I_F2 = 64 * 16 / TD_, I_G = 16 * 16 / TD_, I_PP = 4 * 16 / TD_;
    constexpr int PER_LAYER = I_IN + I_OUT + I_F1 + I_F2 + I_G + I_PP;
    for (int pw_ = 0; pw_ < PROBE_PRO_W; ++pw_)
    for (int it = Llo * PER_LAYER + gw; it < Lhi * PER_LAYER; it += NGW) {
        const int L = it / PER_LAYER; int r = it % PER_LAYER; const int odd = L & 1, j = L >> 1;
        if (sel >= 0 && !((sel >> ((r < I_IN) ? L : 4 + L)) & 1)) continue;
#if PRO_T3
        LAS unsigned* scr3 = (LAS unsigned*)(lds + wave * 16896);
#define T3_ID(n0_) (n0_), (n0_) + 32, (n0_) + 64, (n0_) + 96
        if (r < I_IN) { const int kb = r % 16, nb = r / 16; const int ldw = odd ? 3088 : 3072;
            const float* w16_ = AIN(16); const float* w12_ = AIN(12); const float* W = (odd ? w16_ : w12_) + (size_t)j * 1024 * ldw;
            transpose_item3(W, ldw, 1024, 64 * kb, 128 * nb, (bf16*)(ws + WS_WIN + L * WIN_STRIDE), inproj_row(128 * nb, odd), inproj_row(128 * nb + 32, odd), inproj_row(128 * nb + 64, odd), inproj_row(128 * nb + 96, odd), AIN(11) + L * 1024, scr3, lane); continue; }
        r -= I_IN;
        if (r < I_OUT) { const int kb = r % 16, nb = r / 16; transpose_item3(AIN(20) + (size_t)L * 1024 * 1024, 1024, 1024, 64 * kb, 128 * nb, (bf16*)(ws + WS_WOUT) + (size_t)L * 1024 * 1024, T3_ID(128 * nb), nullptr, scr3, lane); continue; }
        r -= I_OUT;
        if (r < I_F1) { const int kb = r % 16, nb = r / 16; transpose_item3(AIN(22) + (size_t)L * 1024 * 4096, 4096, 1024, 64 * kb, 128 * nb, (bf16*)(ws + WS_WFF1) + (size_t)L * 4096 * 1024, T3_ID(128 * nb), AIN(21) + L * 1024, scr3, lane); continue; }
        r -= I_F1;
        if (r < I_F2) { const int kb = r % 64, nb = r / 64; transpose_item3(AIN(23) + (size_t)L * 4096 * 1024, 1024, 4096, 64 * kb, 128 * nb, (bf16*)(ws + WS_WFF2) + (size_t)L * 1024 * 4096, T3_ID(128 * nb), nullptr, scr3, lane); continue; }
        r -= I_F2;
        if (r < I_G) { const int kb = r % 16, nb = r / 16; transpose_item3(AIN(25) + (size_t)L * 1024 * 1024, 1024, 1024, 64 * kb, 128 * nb, (bf16*)(ws + WS_WG) + (size_t)L * 1024 * 1024, T3_ID(128 * nb), AIN(24) + L * 1024, scr3, lane); continue; }
        r -= I_G;
        { const int kb = r % 4, nb = r / 4; transpose_item3(AIN(26) + (size_t)L * 256 * 1024, 1024, 256, 64 * kb, 128 * nb, (bf16*)(ws + WS_WPP) + (size_t)L * 1024 * 256, T3_ID(128 * nb), nullptr, scr3, lane); }
#elif PRO_T2
        if (r < I_IN) { const int kb = r % 8, nb = r / 8; const int ldw = odd ? 3088 : 3072;
            const float* w16_ = AIN(16); const float* w12_ = AIN(12); const float* W = (odd ? w16_ : w12_) + (size_t)j * 1024 * ldw;
            transpose_item2(W, ldw, 1024, 128 * kb, 32 * nb, (bf16*)(ws + WS_WIN + L * WIN_STRIDE), inproj_row(32 * nb, odd), AIN(11) + L * 1024, scr, lane); continue; }
        r -= I_IN;
        if (r < I_OUT) { const int kb = r % 8, nb = r / 8; transpose_item2(AIN(20) + (size_t)L * 1024 * 1024, 1024, 1024, 128 * kb, 32 * nb, (bf16*)(ws + WS_WOUT) + (size_t)L * 1024 * 1024, 32 * nb, nullptr, scr, lane); continue; }
        r -= I_OUT;
        if (r < I_F1) { const int kb = r % 8, nb = r / 8; transpose_item2(AIN(22) + (size_t)L * 1024 * 4096, 4096, 1024, 128 * kb, 32 * nb, (bf16*)(ws + WS_WFF1) + (size_t)L * 4096 * 1024, 32 * nb, AIN(21) + L * 1024, scr, lane); continue; }
        r -= I_F1;
        if (r < I_F2) { const int kb = r % 32, nb = r / 32; transpose_item2(AIN(23) + (size_t)L * 4096 * 1024, 1024, 4096, 128 * kb, 32 * nb, (bf16*)(ws + WS_WFF2) + (size_t)L * 1024 * 4096, 32 * nb, nullptr, scr, lane); continue; }
        r -= I_F2;
        if (r < I_G) { const int kb = r % 8, nb = r / 8; transpose_item2(AIN(25) + (size_t)L * 1024 * 1024, 1024, 1024, 128 * kb, 32 * nb, (bf16*)(ws + WS_WG) + (size_t)L * 1024 * 1024, 32 * nb, AIN(24) + L * 1024, scr, lane); continue; }
        r -= I_G;
        { const int kb = r % 2, nb = r / 2; transpose_item2(AIN(26) + (size_t)L * 256 * 1024, 1024, 256, 128 * kb, 32 * nb, (bf16*)(ws + WS_WPP) + (size_t)L * 1024 * 256, 32 * nb, nullptr, scr, lane); }
#else
        if (r < I_IN) { int kb, nb; PRO_DECODE(r, 16, 48, kb, nb); const int ldw = odd ? 3088 : 3072;
            const float* w16_ = AIN(16); const float* w12_ = AIN(12); const float* W = (odd ? w16_ : w12_) + (size_t)j * 1024 * ldw;
            transpose_item(W, ldw, 1024, 64 * kb, 64 * nb, (bf16*)(ws + WS_WIN + L * WIN_STRIDE), inproj_row(64 * nb, odd), inproj_row(64 * nb + 32, odd), AIN(11) + L * 1024, scr, lane); continue; }
        r -= I_IN;
        if (r < I_OUT) { int kb, nb; PRO_DECODE(r, 16, 16, kb, nb); transpose_item(AIN(20) + (size_t)L * 1024 * 1024, 1024, 1024, 64 * kb, 64 * nb, (bf16*)(ws + WS_WOUT) + (size_t)L * 1024 * 1024, 64 * nb, 64 * nb + 32, nullptr, scr, lane); continue; }
        r -= I_OUT;
        if (r < I_F1) { int kb, nb; PRO_DECODE(r, 16, 64, kb, nb); transpose_item(AIN(22) + (size_t)L * 1024 * 4096, 4096, 1024, 64 * kb, 64 * nb, (bf16*)(ws + WS_WFF1) + (size_t)L * 4096 * 1024, 64 * nb, 64 * nb + 32, AIN(21) + L * 1024, scr, lane); continue; }
        r -= I_F1;
        if (r < I_F2) { int kb, nb; PRO_DECODE(r, 64, 16, kb, nb); transpose_item(AIN(23) + (size_t)L * 4096 * 1024, 1024, 4096, 64 * kb, 64 * nb, (bf16*)(ws + WS_WFF2) + (size_t)L * 1024 * 4096, 64 * nb, 64 * nb + 32, nullptr, scr, lane); continue; }
        r -= I_F2;
        if (r < I_G) { int kb, nb; PRO_DECODE(r, 16, 16, kb, nb); transpose_item(AIN(25) + (size_t)L * 1024 * 1024, 1024, 1024, 64 * kb, 64 * nb, (bf16*)(ws + WS_WG) + (size_t)L * 1024 * 1024, 64 * nb, 64 * nb + 32, AIN(24) + L * 1024, scr, lane); continue; }
        r -= I_G;
        { int kb, nb; PRO_DECODE(r, 4, 16, kb, nb); transpose_item(AIN(26) + (size_t)L * 256 * 1024, 1024, 256, 64 * kb, 64 * nb, (bf16*)(ws + WS_WPP) + (size_t)L * 1024 * 256, 64 * nb, 64 * nb + 32, nullptr, scr, lane); }
#endif
    }
    for (int it = gw; it < 2 * 256 * 2; it += NGW) {
        const int j = it >> 9, row = (it >> 1) & 255, k = (it & 1) * 512 + lane * 8, L = 2 * j + 1;
        if (L < Llo || L >= Lhi) continue;
        if (sel >= 0 && !((sel >> L) & 1)) continue;
        v4u o = (v4u){0u, 0u, 0u, 0u};
        if (row < 16) { const float* W = AIN(16) + (size_t)j * 1024 * 3088 + 3072 + row; const float* g = AIN(11) + L * 1024; float v[8];
#pragma unroll
            for (int i = 0; i < 8; ++i) v[i] = W[(size_t)(k + i) * 3088] * g[k + i];
            o.x = cvtpk_h(v[0], v[1]); o.y = cvtpk_h(v[2], v[3]); o.z = cvtpk_h(v[4], v[5]); o.w = cvtpk_h(v[6], v[7]); }
        *(GAS v4u*)((bf16*)(ws + WS_WIN + L * WIN_STRIDE) + (size_t)(3072 + row) * 1024 + k) = o;
    }
    for (int ps2_ = 0; ps2_ < PROBE_PRO_S; ++ps2_)
    for (int it = Llo * (MROWS * 256 / 2048) + gw; it < Lhi * (MROWS * 256 / 2048); it += NGW) {
        if (sel >= 0 && !((sel >> (8 + it / (MROWS * 256 / 2048))) & 1)) continue;
        f32x4 a[4], b[4]; size_t e[4];
#pragma unroll
        for (int q = 0; q < 4; ++q) { e[q] = (size_t)it * 2048 + q * 512 + lane * 8; const int i = (int)(e[q] / ((size_t)MROWS * 256)); const size_t rem = e[q] % ((size_t)MROWS * 256); const int row = (int)(rem >> 8), c = (int)(rem & 255);
            const float* p9_ = AIN(9); const float* p10_ = AIN(10); const float* src = (row < SEQ) ? p9_ + ((size_t)i * SEQ + row) * 256 + c : p10_ + ((size_t)i * NSMP + (row - SEQ)) * 256 + c;
            a[q] = __builtin_nontemporal_load((const f32x4*)src); b[q] = __builtin_nontemporal_load((const f32x4*)(src + 4)); }
#pragma unroll
        for (int q = 0; q < 4; ++q) { v4u o; o.x = cvtpk_h(a[q][0], a[q][1]); o.y = cvtpk_h(a[q][2], a[q][3]); o.z = cvtpk_h(b[q][0], b[q][1]); o.w = cvtpk_h(b[q][2], b[q][3]);
            *(GAS v4u*)((bf16*)(ws + WS_PB) + e[q]) = o; }
    }
    if (do_x)
    for (int ps3_ = 0; ps3_ < PROBE_PRO_S; ++ps3_)
    for (int rp = gw; rp < MROWS / 2; rp += NGW) {
        f32x4 v[2][4];
#pragma unroll
        for (int h2 = 0; h2 < 2; ++h2) { const int row = 2 * rp + h2; const float* x0_ = AIN(0); const float* x1_ = AIN(1); const float* xr = (row < SEQ) ? x0_ + (size_t)row * DM : x1_ + (size_t)(row - SEQ) * DM;
#pragma unroll
            for (int q = 0; q < 4; ++q) v[h2][q] = __builtin_nontemporal_load((const f32x4*)xr + lane + 64 * q); }
#pragma unroll
        for (int h2 = 0; h2 < 2; ++h2) { const int row = 2 * rp + h2; float s = 0.f;
#pragma unroll
            for (int q = 0; q < 4; ++q) s += (v[h2][q][0] * v[h2][q][0] + v[h2][q][1] * v[h2][q][1]) + (v[h2][q][2] * v[h2][q][2] + v[h2][q][3] * v[h2][q][3]);
            s = wave_sum(s);
            GAS unsigned long long* o8 = (GAS unsigned long long*)((bf16*)(ws + WS_HB0) + (size_t)row * DM) + lane;
#pragma unroll
            for (int q = 0; q < 4; ++q) o8[64 * q] = (unsigned long long)cvtpk_h(v[h2][q][0], v[h2][q][1]) | ((unsigned long long)cvtpk_h(v[h2][q][2], v[h2][q][3]) << 32);
            if (lane < 16) ((float*)(ws + WS_SSQ0))[(size_t)row * 16 + lane] = (lane == 0) ? s : 0.f; }
    }
    constexpr int CH4 = 496 * 512 / 4;
    if (do_band)
    for (int ps4_ = 0; ps4_ < PROBE_PRO_S; ++ps4_)
    for (int it = gw; it < 2 * 2 * 16 * (CH4 / 512); it += NGW) {
        const int chunk = it / (CH4 / 512), part = it % (CH4 / 512); const int tz = chunk >> 5, jb = chunk & 31;
        const float* c5_ = AIN(5); const float* c4_ = AIN(4); const f32x4* src = (const f32x4*)((tz ? c5_ : c4_) + (size_t)jb * 512 * 512 + 16 * 512) + (size_t)part * 512 + lane;
        f32x4* dst = (f32x4*)(as_global(Ak->out) + (tz ? O_SBV : O_SBK) + (size_t)jb * 512 * 512) + (size_t)part * 512 + lane;
        f32x4 t[8];
#pragma unroll
        for (int q = 0; q < 8; ++q) t[q] = __builtin_nontemporal_load(src + 64 * q);
#pragma unroll
        for (int q = 0; q < 8; ++q) __builtin_nontemporal_store(t[q], dst + 64 * q);
    }
}
#undef AIN

__device__ __forceinline__ void scan_seq(const float* src0, int n0, const float* src1, int n1, double* dst, LAS unsigned char* lds, int tid_in) {
    int tid = tid_in; asm volatile("" : "+v"(tid));
    LAS double* wsum = (LAS double*)lds;
    const int n = n0 + n1, chunk = (n + 511) / 512, s0 = tid * chunk; int cnt = n - s0; cnt = cnt < 0 ? 0 : (cnt > chunk ? chunk : cnt);
    float x[32];
#pragma unroll
    for (int i = 0; i < 32; ++i) { const int s = s0 + i; const float* p = (s < n0) ? src0 + (size_t)s * 16 : src1 + (size_t)(s - n0) * 16; x[i] = (i < cnt) ? *p : 0.f; }
    double acc = 0.0;
#pragma unroll
    for (int i = 0; i < 32; ++i) acc += (double)x[i];
    const int lane = tid & 63, w = tid >> 6;
    double inc = acc;
#pragma unroll
    for (int o = 1; o < 64; o <<= 1) { const double t = __shfl_up(inc, o); if (lane >= o) inc += t; }
    if (lane == 63) wsum[w] = inc;
    __syncthreads();
    double base = 0.0;
#pragma unroll
    for (int ww = 0; ww < 8; ++ww) if (ww < w) base += wsum[ww];
    double run = base + inc - acc;
#pragma unroll
    for (int i = 0; i < 32; ++i) { run += (double)x[i]; if (i < cnt) dst[s0 + i] = run; }
    __syncthreads();
}

#ifndef DEFER_L1
#define DEFER_L1 0
#endif
#ifndef FOX_THRL
#define FOX_THRL 8
#endif
#ifndef PG8_SP2
#define PG8_SP2 true
#endif
#ifndef PG8_ALIGN_IN
#define PG8_ALIGN_IN true
#endif
#ifndef PG8_ALIGN_FF1
#define PG8_ALIGN_FF1 true
#endif
#ifndef N_DEFER_UNITS
#define N_DEFER_UNITS 512
#endif
#ifndef PROBE_REP_PA
#define PROBE_REP_PA 1
#endif
#ifndef PROBE_REP_PB
#define PROBE_REP_PB 1
#endif
#ifndef PROBE_FILL
#define PROBE_FILL 1
#endif
#ifndef PROBE_REP_SMPC
#define PROBE_REP_SMPC 1
#endif
#ifndef SMP_RATIO
#define SMP_RATIO 3
#endif
#ifndef FF2_ST
#define FF2_ST 8
#endif
#ifndef EXP_REBALANCE
#define EXP_REBALANCE 1
#endif
#ifndef EXP_OVERLAP
#define EXP_OVERLAP 0
#endif
#ifndef PP_EARLY
#define PP_EARLY 0
#endif
#ifndef STICK_PRE
#define STICK_PRE 1
#endif
#ifndef XCDQ
#define XCDQ 0
#endif
#ifndef STATIC_FIRST
#define STATIC_FIRST 0
#endif
#ifndef FILL_SPREAD
#define FILL_SPREAD 1
#endif
#ifndef DEFER_SPLIT
#define DEFER_SPLIT 1
#endif
#ifndef EVEN_PARITY
#define EVEN_PARITY 1
#endif
#ifndef L0_CONV
#define L0_CONV 0
#endif
#ifndef TICKET_PREFETCH
#define TICKET_PREFETCH 0
#endif
#ifndef PROBE_REP_SMPE
#define PROBE_REP_SMPE 1
#endif
#ifndef PROBE_REP_EXPE
#define PROBE_REP_EXPE 1
#endif
#ifndef DBASE_OFF
#define DBASE_OFF 118784
#endif
#ifndef PROBE_REP_SCAN
#define PROBE_REP_SCAN 1
#endif
#ifndef PROBE_REP_BAR
#define PROBE_REP_BAR 1
#endif
#ifndef SKIP_BASE
#define SKIP_BASE 160.0f
#endif
#ifndef RES_OUT
#define RES_OUT residual16<4>
#endif
#ifndef BAND_ON_FOX
#define BAND_ON_FOX 1
#endif
#ifndef PROBE_REP_SMMIN
#define PROBE_REP_SMMIN 1
#endif
#ifndef PROBE_REP_SMM
#define PROBE_REP_SMM 1
#endif
#ifndef PROBE_REP_PRO
#define PROBE_REP_PRO 1
#endif
#ifndef PROBE_REP_IN
#define PROBE_REP_IN 1
#endif
#ifndef PROBE_REP_OUT
#define PROBE_REP_OUT 1
#endif
#ifndef PROBE_REP_FF1
#define PROBE_REP_FF1 1
#endif
#ifndef PROBE_REP_FF2
#define PROBE_REP_FF2 1
#endif
#ifndef PROBE_REP_PLE
#define PROBE_REP_PLE 1
#endif
#ifndef PROBE_ATT_REP
#define PROBE_ATT_REP 1
#define PROBE_ATT_PAR 0
#endif
#ifndef SKIP_IN
#define SKIP_IN 0
#endif
#ifndef SKIP_OUT
#define SKIP_OUT 0
#endif
#ifndef SKIP_FF1
#define SKIP_FF1 0
#endif
#ifndef SKIP_FF2
#define SKIP_FF2 0
#endif
#ifndef SKIP_PLE
#define SKIP_PLE 0
#endif
constexpr int N_PHASES = 1 + 7 * DEPTH;
__global__ void __launch_bounds__(NWAVES * 64, 2) fwd_kernel(Args args) {
    extern __shared__ __attribute__((aligned(16))) unsigned char lds_raw[];
    LAS unsigned char* lds = (LAS unsigned char*)lds_raw;
    volatile LAS unsigned* MISC = (volatile LAS unsigned*)(lds + MISC_OFF);
    const int tid0 = threadIdx.x, G0 = gridDim.x, bx0 = blockIdx.x; const int wave0 = __builtin_amdgcn_readfirstlane(tid0 >> 6);
    for (int u = tid0; u < (LDS_BYTES - MISC_OFF) / 4; u += NWAVES * 64) ((LAS unsigned*)(lds + MISC_OFF))[u] = 0u;
    __syncthreads();
    KArgs kp0 = (KArgs)__builtin_amdgcn_kernarg_segment_ptr();
    unsigned char* ws = args.ws;
    XcdBarrier bar; bar.bar = (unsigned*)(ws + WS_CTL) + CW_BAR; bar.x = 0; bar.st = nullptr;
    if (!N_LAUNCH_PER_PHASE) bar = xcd_barrier_post((unsigned*)(ws + WS_CTL) + CW_BAR, MISC + 8);
#define PHASE_IDS int wv_ = wave0; asm volatile("" : "+s"(wv_)); int ln_; asm volatile("v_mbcnt_lo_u32_b32 %0, -1, 0\n\tv_mbcnt_hi_u32_b32 %0, -1, %0" : "=v"(ln_)); \
    const int tid = wv_ * 64 + ln_, lane = ln_, wave = wv_; (void)lane; (void)wave
#define GRID_BAR() do { if (!N_LAUNCH_PER_PHASE) { XcdBarrier b_ = bar; asm volatile("" : "+s"(b_.bar), "+s"(b_.x)); b_.bar = (unsigned*)(GAS unsigned*)b_.bar; int bw_ = wave0; asm volatile("" : "+s"(bw_)); int bl_; asm volatile("v_mbcnt_lo_u32_b32 %0, -1, 0\n\tv_mbcnt_hi_u32_b32 %0, -1, %0" : "=v"(bl_)); for (int pbar_ = 0; pbar_ < PROBE_REP_BAR; ++pbar_) xcd_barrier(b_, bw_ * 64 + bl_); } } while (0)
    const int lo = args.ph_lo, hi = args.ph_hi;
#define IN(k) (lo <= (k) && (k) < hi)
#define BOTH(k) (IN(k) && ((k) + 1 < hi))

#ifndef SKIP_PRO
    for (int rp_ = 0; rp_ < PROBE_REP_PRO; ++rp_)
    if (IN(0)) { const int vcu = (G0 % 8 == 0) ? (bx0 % 8) * (G0 / 8) + bx0 / 8 : bx0; convert_inputs(kp0, lds, vcu * NWAVES + wave0, G0 * NWAVES, wave0, tid0 & 63, 0, (N_DEFER_UNITS > 0) ? (DEFER_L1 ? 1 : 2) : DEPTH, true, N_DEFER_UNITS == 0, DEFER_SPLIT ? (L0_CONV ? 0x003 : 0x113) : -1); if (BOTH(0)) GRID_BAR(); }
#endif

    for (int L = 0; L < DEPTH; ++L) {
        const int pb = 1 + 7 * L, odd = L & 1, j = L >> 1, cur = L & 1;
        int bx = bx0, G = G0; asm volatile("" : "+s"(bx), "+s"(G));
        KArgs kp = kp0; asm volatile("" : "+s"(kp));
        unsigned char* ws = as_global(kp->ws); float* out = as_global(kp->out); float* Y = out + O_Y;
        bf16* Qb = (bf16*)(ws + WS_Q); bf16* Kb = (bf16*)(ws + WS_K); bf16* Vb = (bf16*)(ws + WS_V); bf16* Ob = (bf16*)(ws + WS_O); bf16* HID = (bf16*)(ws + WS_HID); bf16* PP = (bf16*)(ws + WS_PP);
        double* Dp = (double*)(ws + WS_DP); double* Ds = (double*)(ws + WS_DS);
        bf16* HBc = (bf16*)(ws + (cur ? WS_HB1 : WS_HB0)); bf16* HBn = (bf16*)(ws + (cur ? WS_HB0 : WS_HB1));
        float* SSc = (float*)(ws + (cur ? WS_SSQ1 : WS_SSQ0)); float* SSn = (float*)(ws + (cur ? WS_SSQ0 : WS_SSQ1));
        for (int pr_ = PROBE_REP_IN; pr_ > 0; --pr_)
        if (!SKIP_IN && IN(pb)) {
            PHASE_IDS;
            const bf16* Win_ = (const bf16*)(ws + WS_WIN + L * WIN_STRIDE);
            pg8::Gemm g{HBc, Win_, SEQ, 3072, DM}; pg8::StaticOrder S; S.init(SEQ, 3072, G, bx);
            const float* gq_ = (odd ? as_global(kp->in[18]) : as_global(kp->in[13])) + j * 64; const float* gk_ = (odd ? as_global(kp->in[19]) : as_global(kp->in[14])) + j * 64;
            for (int ps_ = 0; ps_ < PROBE_REP_SMM * PROBE_REP_SMMIN; ++ps_) smm::in_proj(HBc, Win_, SSc, Qb, out, gq_, gk_, as_global(kp->in[17]) + j * 16, odd, j, (float*)(ws + WS_DP), (double*)(ws + WS_TT), lds, bx, G, tid);
            pg8::EpiIn E{SSc, Qb, out, gq_, (long long)((const char*)gk_ - (const char*)gq_), odd, j};
            pg8::gemm_phase<pg8::EpiIn, pg8::StaticOrder, PG8_ALIGN_IN, PG8_SP2>(lds + RING_OFF, g, S, E, tid);
            if (BOTH(pb)) GRID_BAR();
        }
#ifndef SKIP_ATT
        for (int rep_ = 0; rep_ < ((PROBE_ATT_REP > 1 && odd == PROBE_ATT_PAR) ? PROBE_ATT_REP : 1); ++rep_)
        if (IN(pb + 2)) {
            PHASE_IDS;
            const att::bf16 *Qg = Qb, *Kg = Kb, *Vg = Vb; att::bf16* Og = Ob;
            if (!odd) {
                for (int pa_ = 0; pa_ < PROBE_REP_PA; ++pa_)
                for (int x = bx * 8 + wave; x < 4096; x += 8 * G) att::stick_wave_unit(x & 7, x >> 3, Qg, Kg, Vg, Og, lds + wave * att::SW_BYTES, lane);
#if L0_CONV
                if (L == 0) convert_inputs(kp0, lds, bx * NWAVES + wave, G * NWAVES, wave, lane, 0, 1, false, false, 0x110);
#endif
                __syncthreads();
#if EVEN_PARITY
                const bool memfirst_ = (G == 256) && (bx & 1);
#define EVEN_MEM_STAGE() do { if (G == 256) { if (bx < 128) smm::expand_kv(bx, Kb, out, 0, j, tid); else for (int i_ = 0; i_ < 3; ++i_) smm::expand_kv(128 + (bx - 128) * 3 + i_, Kb, out, 0, j, tid); } } while (0)
                if (memfirst_) { EVEN_MEM_STAGE(); __syncthreads(); }
#endif
                for (int pb_ = 0; pb_ < PROBE_REP_PB; ++pb_)
                for (int u = bx; u < 512; u += G) {
#if BAND_ON_FOX
                    fox::band_unit<8>(8 + (u & 7), u >> 3, as_global(kp->in[15]) + (size_t)(j * 8 + (u & 7)) * 257, (const fox::bf16*)Qg, (const fox::bf16*)Kg, (const fox::bf16*)Vg, (fox::bf16*)Og, (__attribute__((address_space(3))) char*)lds, tid);
#else
                    att::prompt_unit<1>(8 + (u & 7), u >> 3, Qg, Kg, Vg, Og, lds, nullptr, as_global(kp->in[15]) + (size_t)(j * 8 + (u & 7)) * 257, tid);
#endif
                }
#if EVEN_PARITY
                if (!memfirst_) { __syncthreads(); EVEN_MEM_STAGE(); }
                __syncthreads();
#endif
#if EXP_OVERLAP
                if (G == 256) {
                    const int b = (bx & 127) >> 3, hl = bx & 7;
                    if (bx < 128) {
                        if (wave == 0) {
                            att::SmpSrc S{as_global(kp->in[2]) + (size_t)(j * 16 + b) * PAST * 512, as_global(kp->in[3]) + (size_t)(j * 16 + b) * PAST * 512, PAST, 8, hl, Kg + (size_t)(SEQ + b * 16) * DM + hl * 64, Vg + (size_t)(SEQ + b * 16) * DM + hl * 64};
                            att::sample_unit_wave<0>(S, b, hl, Qg, Og, lds, nullptr, lane);
                        } else { smm::expand_kv_even_waves(2 * bx, Kb, out, j, lane, wave - 1, 7); smm::expand_kv_even_waves(2 * bx + 1, Kb, out, j, lane, wave - 1, 7); }
                    } else {
                        att::SmpSrc S{as_global(kp->in[4]) + (size_t)(j * 16 + b) * BANDL * 512, as_global(kp->in[5]) + (size_t)(j * 16 + b) * BANDL * 512, BANDL, 8, hl, Kg + (size_t)(SEQ + b * 16) * DM + (8 + hl) * 64, Vg + (size_t)(SEQ + b * 16) * DM + (8 + hl) * 64};
                        att::sample_unit_split<1>(S, b, 8 + hl, Qg, Og, lds, nullptr, as_global(kp->in[15]) + (size_t)(j * 8 + hl) * 257, tid);
                        smm::expand_kv(2 * bx, Kb, out, 0, j, tid); smm::expand_kv(2 * bx + 1, Kb, out, 0, j, tid);
                    }
                } else
#endif
                {
                for (int pse_ = 0; pse_ < PROBE_REP_SMPE; ++pse_)
                for (int x = bx; x < 256; x += G) {
                    const int b = (x & 127) >> 3, hl = x & 7;
                    if (x < 128) {
#if STICK_PRE
                        { att::SmpSrc S{as_global(kp->in[2]) + (size_t)(j * 16 + b) * PAST * 512, as_global(kp->in[3]) + (size_t)(j * 16 + b) * PAST * 512, PAST, 8, hl, Kg + (size_t)(SEQ + b * 16) * DM + hl * 64, Vg + (size_t)(SEQ + b * 16) * DM + hl * 64};
                          att::sample_unit_stick_pre(S, b, hl, Qg, Og, lds, wave, lane); }
#else
                        if (wave == 0) {
                            att::SmpSrc S{as_global(kp->in[2]) + (size_t)(j * 16 + b) * PAST * 512, as_global(kp->in[3]) + (size_t)(j * 16 + b) * PAST * 512, PAST, 8, hl, Kg + (size_t)(SEQ + b * 16) * DM + hl * 64, Vg + (size_t)(SEQ + b * 16) * DM + hl * 64};
                            att::sample_unit_wave<0>(S, b, hl, Qg, Og, lds, nullptr, lane);
                        }
#endif
                        __syncthreads();
                    } else {
                        att::SmpSrc S{as_global(kp->in[4]) + (size_t)(j * 16 + b) * BANDL * 512, as_global(kp->in[5]) + (size_t)(j * 16 + b) * BANDL * 512, BANDL, 8, hl, Kg + (size_t)(SEQ + b * 16) * DM + (8 + hl) * 64, Vg + (size_t)(SEQ + b * 16) * DM + (8 + hl) * 64};
                        att::sample_unit_split<1>(S, b, 8 + hl, Qg, Og, lds, nullptr, as_global(kp->in[15]) + (size_t)(j * 8 + hl) * 257, tid);
                    }
                }
                if (!EVEN_PARITY || G != 256)
                for (int pxe_ = 0; pxe_ < PROBE_REP_EXPE; ++pxe_)
#if EXP_REBALANCE
                if (G == 256) {
                    if (bx < 128) smm::expand_kv(bx, Kb, out, 0, j, tid);
                    else for (int i_ = 0; i_ < 3; ++i_) smm::expand_kv(128 + (bx - 128) * 3 + i_, Kb, out, 0, j, tid);
                } else
#endif
                for (int u = bx; u < 512; u += G) smm::expand_kv(u, Kb, out, 0, j, tid);
                }
                __syncthreads();
                if (DEFER_L1 && N_DEFER_UNITS > 0 && L == 0) { convert_inputs(kp0, lds, bx * NWAVES + wave, G * NWAVES, wave, lane, 1, 2, false, false); __syncthreads(); }
            } else {
                float gqm = fabsf(as_global(kp->in[18])[j * 64 + lane]), gkm = fabsf(as_global(kp->in[19])[j * 64 + lane]);
#pragma unroll
                for (int o_ = 1; o_ < 64; o_ <<= 1) { gqm = fmaxf(gqm, __shfl_xor(gqm, o_)); gkm = fmaxf(gkm, __shfl_xor(gkm, o_)); }
                const float skip_thr = __int_as_float(__builtin_amdgcn_readfirstlane(__float_as_int(-(SKIP_BASE + 2.0f * 1.02f * (64.0f * 0.125f * LOG2E) * gqm * gkm))));
                unsigned* qctr = (unsigned*)(ws + WS_CTL) + CW_QUEUE + 64 * (L * 4 + rep_) * (XCDQ ? 8 : 1);
                const int nq_ = 224 + ((L == 1) ? 64 : 0); (void)nq_;
                volatile LAS int* qslot = (volatile LAS int*)(lds + MISC_OFF + 64);
                if (STATIC_FIRST && tid == 0) qslot[3] = 0;
                unsigned tk = 0;
                if (TICKET_PREFETCH && tid == 0) tk = __hip_atomic_fetch_add(qctr, 1u, __ATOMIC_RELAXED, __HIP_MEMORY_SCOPE_AGENT);
#if XCDQ
                static_assert(N_DEFER_UNITS == 512 && PROBE_FILL == 1 && SMP_RATIO == 4, "per-XCD queue layout");
                volatile LAS int* qoffp = (volatile LAS int*)(lds + MISC_OFF + 80);
                if (tid == 0) *qoffp = 0;
#endif
                for (;;) {
#if XCDQ
                    if (tid == 0) { const int qo0_ = *qoffp, qi0_ = ((int)__builtin_amdgcn_workgroup_id_x() + qo0_) & 7;
                        const unsigned tk_ = __hip_atomic_fetch_add(qctr + 64 * qi0_, 1u, __ATOMIC_RELAXED, __HIP_MEMORY_SCOPE_AGENT);
                        const bool ex_ = tk_ >= (unsigned)nq_; if (ex_) *qoffp = qo0_ + 1;
                        *qslot = ex_ ? (qo0_ == 7 ? -2 : -1) : (int)(tk_ | ((unsigned)qi0_ << 16)); }
                    __syncthreads();
                    const int w_ = __builtin_amdgcn_readfirstlane(*qslot);
                    __syncthreads();
                    if (w_ == -2) break;
                    if (w_ == -1) continue;
                    const int t_ = w_ & 0xffff, qi = w_ >> 16;
                    int u;
                    if (t_ >= 224) u = 1792 + (t_ - 224) * 8 + qi;
                    else if (t_ >= 160) u = 1280 + (t_ - 160) * 8 + qi;
                    else if (t_ < 128 && (t_ & 3) == 3) { const int si = t_ >> 2; u = ((si >> 1) * 16 + 2 * qi + (si & 1)) * 4 + 3; }
                    else { const int pi = (t_ < 128) ? t_ - (t_ >> 2) : t_ - 32; const int up_ = (pi >> 1) * 16 + 2 * qi + (pi & 1); u = (up_ < 768) ? up_ + up_ / 3 : up_ + 256; }
                    asm volatile("" : "+s"(u));
                    const int n_exp = 512 * PROBE_FILL;
#else
#if STATIC_FIRST
                    if (tid == 0) { const int nf_ = qslot[3]; qslot[3] = 1; *qslot = nf_ ? (int)(G + __hip_atomic_fetch_add(qctr, 1u, __ATOMIC_RELAXED, __HIP_MEMORY_SCOPE_AGENT)) : bx; }
#else
                    if (!TICKET_PREFETCH && tid == 0) tk = __hip_atomic_fetch_add(qctr, 1u, __ATOMIC_RELAXED, __HIP_MEMORY_SCOPE_AGENT);
                    if (tid == 0) *qslot = (int)tk;
#endif
                    __syncthreads();
#if FILL_SPREAD
                    static_assert(N_DEFER_UNITS == 512 && PROBE_FILL == 1, "filler interleave layout");
                    const int raw_ = __builtin_amdgcn_readfirstlane(*qslot);
                    __syncthreads();
                    const int n_exp = 512, n_def = (L == 1) ? 512 : 0;
                    int u;
                    if (L == 1) { if (raw_ >= 256 * 9) break; const int per_ = raw_ / 9, r_ = raw_ % 9;
                        if (r_ < 5) u = per_ * 5 + r_; else { const int f_ = per_ * 4 + (r_ - 5); u = 1280 + ((f_ & 1) ? 512 + (f_ >> 1) : (f_ >> 1)); } }
#if DEFER_SPLIT
                    else { if (raw_ >= 256 * 8) break; const int per_ = raw_ >> 3, r_ = raw_ & 7;
                        if (r_ < 5) u = per_ * 5 + r_; else u = 1280 + ((r_ == 7) ? 512 + per_ : per_ * 2 + (r_ - 5)); }
#else
                    else { if (raw_ >= 256 * 7) break; const int per_ = raw_ / 7, r_ = raw_ % 7;
                        if (r_ < 5) u = per_ * 5 + r_; else u = 1280 + per_ * 2 + (r_ - 5); }
#endif
                    asm volatile("" : "+s"(u));
                    (void)n_def;
#else
                    const int u = __builtin_amdgcn_readfirstlane(*qslot);
                    __syncthreads();
                    const int n_exp = 512 * PROBE_FILL, n_def = (L == 1) ? N_DEFER_UNITS : 0;
                    if (u >= 256 + 1024 + n_exp + n_def) break;
#endif
#endif
#if TICKET_PREFETCH
                    if (tid == 0) tk = __hip_atomic_fetch_add(qctr, 1u, __ATOMIC_RELAXED, __HIP_MEMORY_SCOPE_AGENT);
#endif
                    if (u >= 256 + 1024 + n_exp) {
#if DEFER_SPLIT
                        if (L == 1) convert_inputs(kp0, lds, (u - 1280 - n_exp) * NWAVES + wave, 512 * NWAVES, wave, lane, 1, 4, false, true, 0x66C);
                        else convert_inputs(kp0, lds, (u - 1280 - n_exp) * NWAVES + wave, 256 * NWAVES, wave, lane, 3, 4, false, false, 0x880);
#else
                        convert_inputs(kp0, lds, (u - 1280 - n_exp) * NWAVES + wave, (N_DEFER_UNITS > 0 ? N_DEFER_UNITS : 1) * NWAVES, wave, lane, 2, 4, false, true);
#endif
                        continue; }
                    if (u >= 256 + 1024) { smm::expand_kv((u - 1280) & 511, Kb, out, 1, j, tid); continue; }
                    const bool is_smp = (u < 256 * SMP_RATIO) && (u % SMP_RATIO == SMP_RATIO - 1); const int us = u / SMP_RATIO, up = (u < 256 * SMP_RATIO) ? u - u / SMP_RATIO : u - 256;
                    if (is_smp) { const int b = us >> 4, h = us & 15;
                        att::SmpSrc S{as_global(kp->in[6]) + (size_t)(j * 16 + b) * PAST * 1024, as_global(kp->in[7]) + (size_t)(j * 16 + b) * PAST * 1024, PAST, 16, h, Kg + (size_t)(SEQ + b * 16) * DM + h * 64, Vg + (size_t)(SEQ + b * 16) * DM + h * 64};
                        scan_seq(as_global(kp->in[8]) + ((size_t)(j * 16 + b) * PAST) * 16 + h, PAST, out + O_SCF + (size_t)(j * NSMP + b * 16) * 16 + h, 16, Ds + (size_t)us * (PAST + 16), lds, tid);
                        for (int pc_ = 0; pc_ < PROBE_REP_SMPC; ++pc_) att::sample_unit_split<2>(S, b, h, Qg, Og, lds, Ds + (size_t)us * (PAST + 16), nullptr, tid);
                    } else { const int v = up, qb = 63 - (v >> 4), h = v & 15; const float* LPh = (const float*)(ws + WS_DP) + (size_t)h * SEQ;
                        LAS double* dbase = (LAS double*)(lds + DBASE_OFF);
                        volatile LAS int* qcnt = (volatile LAS int*)(lds + MISC_OFF + 72);
                        if (wave == 0) { int ln_ = lane; asm volatile("" : "+v"(ln_));
                            const double* Th = (const double*)(ws + WS_TT) + h * 256 + 4 * ln_; const double t0_ = Th[0], t1_ = Th[1], t2_ = Th[2], t3_ = Th[3];
                            const float* LPl = LPh + 256 * ln_ + 63; const float l0_ = LPl[0], l1_ = LPl[64], l2_ = LPl[128], l3_ = LPl[192]; const float lq_ = LPh[256 * qb];
                            double inc = (t0_ + t1_) + (t2_ + t3_); const double tot = inc;
#pragma unroll
                            for (int o_ = 1; o_ < 64; o_ <<= 1) { const double t_ = __shfl_up(inc, o_); if (ln_ >= o_) inc += t_; }
                            const double ex = inc - tot, d1_ = ex + t0_, d2_ = ex + t0_ + t1_, d3_ = ex + t0_ + t1_ + t2_; dbase[4 * ln_] = ex; dbase[4 * ln_ + 1] = d1_; dbase[4 * ln_ + 2] = d2_; dbase[4 * ln_ + 3] = d3_;
                            const double dq_ = __shfl(ex, qb) + (double)lq_; const int nt = 4 * qb + 4;
                            const bool p0_ = (4 * ln_ < nt) && ((float)(dq_ - (ex + (double)l0_)) * LOG2E < skip_thr), p1_ = (4 * ln_ + 1 < nt) && ((float)(dq_ - (d1_ + (double)l1_)) * LOG2E < skip_thr);
                            const bool p2_ = (4 * ln_ + 2 < nt) && ((float)(dq_ - (d2_ + (double)l2_)) * LOG2E < skip_thr), p3_ = (4 * ln_ + 3 < nt) && ((float)(dq_ - (d3_ + (double)l3_)) * LOG2E < skip_thr);
                            const int c_ = (int)(__popcll(__ballot(p0_)) + __popcll(__ballot(p1_)) + __popcll(__ballot(p2_)) + __popcll(__ballot(p3_)));
                            if (ln_ == 0) *qcnt = c_; }
                        __syncthreads();
                        const int t_first = __builtin_amdgcn_readfirstlane(*qcnt);
                        fox::attn_unit<FOX_THRL>(0, h, qb, t_first & ~1, LPh, (const __attribute__((address_space(3))) double*)dbase, (const fox::bf16*)Qg, (const fox::bf16*)Kg, (const fox::bf16*)Vg, (fox::bf16*)Og, (__attribute__((address_space(3))) char*)lds, tid); }
                }
            }
#if PP_EARLY
            { __syncthreads(); PHASE_IDS; int kple = DPLE; asm volatile("" : "+s"(kple));
              pg8::Gemm g{(const bf16*)(ws + WS_PB) + (size_t)L * MROWS * DPLE, (const bf16*)(ws + WS_WPP) + (size_t)L * DM * DPLE, SEQ, DM, kple}; pg8::StaticOrder S; S.init(SEQ, DM, G, bx);
              pg8::EpiPP E{PP};
              pg8::gemm_phase<pg8::EpiPP, pg8::StaticOrder, true, PG8_SP2>(lds + RING_OFF, g, S, E, tid); }
#endif
            if (BOTH(pb + 2)) GRID_BAR();
        }
#endif
        for (int pr_ = PROBE_REP_OUT; pr_ > 0; --pr_)
        if (!SKIP_OUT && IN(pb + 3)) {
            PHASE_IDS;
            for (int ps_ = 0; ps_ < PROBE_REP_SMM; ++ps_) smm::RES_OUT(Ob, (const bf16*)(ws + WS_WOUT) + (size_t)L * DM * DM, DM, HBc, HBn, SSn, lds, bx, G, tid);
            pg8::Gemm g{Ob, (const bf16*)(ws + WS_WOUT) + (size_t)L * DM * DM, SEQ, DM, DM}; pg8::StaticOrder S; S.init(SEQ, DM, G, bx);
            pg8::EpiRes E{HBc, HBn, SSn};
            pg8::gemm_phase<pg8::EpiRes, pg8::StaticOrder, true, PG8_SP2>(lds + RING_OFF, g, S, E, tid);
            if (BOTH(pb + 3)) GRID_BAR();
        }
        for (int pr_ = PROBE_REP_FF1; pr_ > 0; --pr_)
        if (!SKIP_FF1 && IN(pb + 4)) {
            PHASE_IDS;
            for (int ps_ = 0; ps_ < PROBE_REP_SMM; ++ps_) smm::ff1(HBn, (const bf16*)(ws + WS_WFF1) + (size_t)L * FF * DM, SSn, HID, lds, bx, G, tid);
            pg8::Gemm g{HBn, (const bf16*)(ws + WS_WFF1) + (size_t)L * FF * DM, SEQ, FF, DM}; pg8::StaticOrder S; S.init(SEQ, FF, G, bx);
            pg8::EpiFf1 E{SSn, HID};
            pg8::gemm_phase<pg8::EpiFf1, pg8::StaticOrder, PG8_ALIGN_FF1, PG8_SP2>(lds + RING_OFF, g, S, E, tid);
            if (BOTH(pb + 4)) GRID_BAR();
        }
        for (int pr_ = PROBE_REP_FF2; pr_ > 0; --pr_)
        if (!SKIP_FF2 && IN(pb + 5)) {
            PHASE_IDS;
            for (int ps_ = 0; ps_ < PROBE_REP_SMM; ++ps_) smm::residual16<FF2_ST>(HID, (const bf16*)(ws + WS_WFF2) + (size_t)L * DM * FF, FF, HBn, HBc, SSc, lds, bx, G, tid);
            pg8::Gemm g{HID, (const bf16*)(ws + WS_WFF2) + (size_t)L * DM * FF, SEQ, DM, FF}; pg8::StaticOrder S; S.init(SEQ, DM, G, bx);
            pg8::EpiRes E{HBn, HBc, SSc};
            pg8::gemm_phase<pg8::EpiRes, pg8::StaticOrder, true, PG8_SP2>(lds + RING_OFF, g, S, E, tid);
            if (BOTH(pb + 5)) GRID_BAR();
        }
        for (int pr_ = PROBE_REP_PLE; pr_ > 0; --pr_)
        if (!SKIP_PLE && IN(pb + 6)) {
            { PHASE_IDS;
              for (int ps_ = 0; ps_ < PROBE_REP_SMM; ++ps_) smm::ple16(HBc, (const bf16*)(ws + WS_WG) + (size_t)L * DM * DM, (const bf16*)(ws + WS_PB) + (size_t)L * MROWS * DPLE, (const bf16*)(ws + WS_WPP) + (size_t)L * DM * DPLE, SSc, HBn, SSn, (L == DEPTH - 1) ? Y + (size_t)SEQ * DM : nullptr, lds, bx, G, tid);
#if !PP_EARLY
              int kple = DPLE; asm volatile("" : "+s"(kple));
              pg8::Gemm g{(const bf16*)(ws + WS_PB) + (size_t)L * MROWS * DPLE, (const bf16*)(ws + WS_WPP) + (size_t)L * DM * DPLE, SEQ, DM, kple}; pg8::StaticOrder S; S.init(SEQ, DM, G, bx);
              pg8::EpiPP E{PP};
              pg8::gemm_phase<pg8::EpiPP, pg8::StaticOrder, true, PG8_SP2>(lds + RING_OFF, g, S, E, tid);
#endif
            }
            { PHASE_IDS; pg8::Gemm g{HBc, (const bf16*)(ws + WS_WG) + (size_t)L * DM * DM, SEQ, DM, DM}; pg8::StaticOrder S; S.init(SEQ, DM, G, bx);
              pg8::EpiGate E{SSc, PP, HBc, HBn, SSn, (L == DEPTH - 1) ? Y : nullptr};
              pg8::gemm_phase<pg8::EpiGate, pg8::StaticOrder, true, PG8_SP2>(lds + RING_OFF, g, S, E, tid); }
            if (BOTH(pb + 6)) GRID_BAR();
        }
    }
#undef IN
#undef BOTH
#undef GRID_BAR
}

extern "C" void kernel_launch(void* const* d_in, const int* in_sizes, int n_in, void* d_out, int out_size, void* d_ws, size_t ws_size, hipStream_t stream) {
    static int grid = 0;
    if (grid == 0) {
        if (n_in != 27 || (size_t)out_size != O_END || ws_size < WS_END) { fprintf(stderr, "kernel_launch: unexpected shapes (n_in %d out %d ws %zu); nothing launched\n", n_in, out_size, ws_size); grid = -1; return; }
        int dev = 0, cus = 0, per_cu = 0;
        if (hipGetDevice(&dev) != hipSuccess || hipDeviceGetAttribute(&cus, hipDeviceAttributeMultiprocessorCount, dev) != hipSuccess) { grid = -1; return; }
        if (hipFuncSetAttribute((const void*)fwd_kernel, hipFuncAttributeMaxDynamicSharedMemorySize, LDS_BYTES) != hipSuccess) { fprintf(stderr, "kernel_launch: hipFuncSetAttribute failed\n"); grid = -1; return; }
        if (hipOccupancyMaxActiveBlocksPerMultiprocessor(&per_cu, (const void*)fwd_kernel, NWAVES * 64, LDS_BYTES) != hipSuccess || per_cu < 1)
            fprintf(stderr, "kernel_launch: note: occupancy query reports %d workgroups per CU\n", per_cu);
        (void)hipGetLastError();
        grid = cus;
    }
    if (grid < 0) return;
    if (!N_LAUNCH_PER_PHASE) { if (hipMemsetAsync((char*)d_ws + WS_CTL, 0, CTL_ZERO_BYTES, stream) != hipSuccess) { fprintf(stderr, "kernel_launch: memset failed\n"); return; } }
    Args a{};
    for (int i = 0; i < 27; ++i) a.in[i] = (const float*)d_in[i];
    a.out = (float*)d_out; a.ws = (unsigned char*)d_ws;
    if (N_LAUNCH_PER_PHASE) {
        for (int ph = 0; ph < N_PHASES; ++ph) {
            if (ph >= 1 && ((ph - 1) % 7) == 1 && (((ph - 1) / 7) & 1) == 0) continue;
            a.ph_lo = ph; a.ph_hi = ph + 1;
            hipLaunchKernelGGL(fwd_kernel, dim3(grid), dim3(NWAVES * 64), LDS_BYTES, stream, a);
        }
    } else {
        a.ph_lo = 0; a.ph_hi = N_PHASES;
        hipLaunchKernelGGL(fwd_kernel, dim3(grid), dim3(NWAVES * 64), LDS_BYTES, stream, a);
    }
    const hipError_t le = hipPeekAtLastError();
    if (le != hipSuccess) fprintf(stderr, "kernel_launch: launch failed: %s\n", hipGetErrorName(le));
}
```
